# Optimizing an MI355X kernel written in HIP

```python
import math
import jax
import jax.numpy as jnp
from jax import lax
import numpy as np

D_MODEL = 1024
BATCH = 16
SEQ = 2048
DEPTH = 1

GRID_W = 64
CTX_LEN = 256
MIX_WIDTH = D_MODEL
RET_WIDTH = MIX_WIDTH // 2
RET_HEADS = 4
RET_HEAD_DIM = RET_WIDTH // RET_HEADS
RET_CHUNK = 128
RWKV_WIDTH = MIX_WIDTH - RET_WIDTH
RWKV_HEAD_DIM = 64
RWKV_HEADS = RWKV_WIDTH // RWKV_HEAD_DIM
DECAY_LORA = 64
AAA_LORA = 64
GATE_LORA = 128
D_FF = 4 * D_MODEL
ROPE_BASE = 10000.0
NORM_EPS = 1e-6
GN_EPS = 64e-5
W_DECAY_SCALE = math.exp(-0.5)
RET_COLS = 4 * RET_WIDTH
SHIFT_COLS = 3 * RWKV_WIDTH + DECAY_LORA + AAA_LORA + GATE_LORA
IN_COLS = RET_COLS + SHIFT_COLS

kernel_name = "hybrid_retention_rwkv7_dit_layer"


def rmsnorm(x, g):
    xf = x.astype(jnp.float32)
    y = xf * lax.rsqrt(jnp.mean(xf * xf, axis=-1, keepdims=True) + NORM_EPS)
    return (y * g.astype(jnp.float32)).astype(x.dtype)


def adaln_params(cvec, w_ada, b_ada):
    m = jax.nn.silu(cvec) @ w_ada + b_ada
    return jnp.split(m, 6, axis=-1)


def modulate(h, shift, scale):
    return h * (1 + scale) + shift


def flip_t(a):
    return jnp.flip(a, axis=1)


def split_heads(t, n_heads, head_dim):
    return t.reshape(t.shape[0], t.shape[1], n_heads, head_dim).astype(jnp.float32)


def rope_tables(rows, cols):
    half = RET_HEAD_DIM // 2
    inv = jnp.power(ROPE_BASE, -jnp.arange(0, half, 2, dtype=jnp.float32) / half)
    ang_r = rows.astype(jnp.float32)[:, None] * inv[None, :]
    ang_c = cols.astype(jnp.float32)[:, None] * inv[None, :]
    return (jnp.cos(ang_r), jnp.sin(ang_r), jnp.cos(ang_c), jnp.sin(ang_c))


def rotate_block(x, cos, sin):
    x1, x2 = jnp.split(x, 2, axis=-1)
    cos = cos[None, :, None, :]
    sin = sin[None, :, None, :]
    return jnp.concatenate([x1 * cos - x2 * sin, x1 * sin + x2 * cos], axis=-1)


def apply_rope_2d(x, tables):
    cr, sr, cc, sc = tables
    half = x.shape[-1] // 2
    return jnp.concatenate([rotate_block(x[..., :half], cr, sr), rotate_block(x[..., half:], cc, sc)], axis=-1)


def retention_scan(q, k, v, log_gamma, s0, inclusive):
    bsz, t_len, n_h, _ = q.shape
    dv = v.shape[-1]
    c = RET_CHUNK
    n_chunks = t_len // c

    def chunks(a):
        return a.reshape(bsz, n_chunks, c, n_h, a.shape[-1]).transpose(1, 0, 3, 2, 4)

    idx = jnp.arange(c, dtype=jnp.float32)
    dist = idx[:, None] - idx[None, :]
    mask = (dist >= 0) if inclusive else (dist > 0)
    lg = log_gamma[:, None, None]
    intra_decay = jnp.where(mask[None], jnp.exp(lg * jnp.maximum(dist, 0.0)[None]), 0.0)
    q_decay = jnp.exp(log_gamma[:, None] * (idx + 1.0)[None, :])
    k_decay = jnp.exp(log_gamma[:, None] * (c - 1.0 - idx)[None, :])
    chunk_decay = jnp.exp(log_gamma * c)

    def body(state, inp):
        qc, kc, vc = inp
        scores = jnp.einsum('bhid,bhjd->bhij', qc, kc) * intra_decay
        out = (jnp.einsum('bhij,bhjd->bhid', scores, vc)
               + jnp.einsum('bhid,bhde->bhie', qc * q_decay[..., None], state))
        state = (state * chunk_decay[:, None, None]
                 + jnp.einsum('bhjd,bhje->bhde', kc * k_decay[..., None], vc))
        return state, out

    s_final, outs = lax.scan(body, s0, (chunks(q), chunks(k), chunks(v)))
    out = outs.transpose(1, 0, 3, 2, 4).reshape(bsz, t_len, n_h, dv)
    return out, s_final


def retention_bidir(q, k, v, log_g, s0_fwd, s0_bwd):
    o_f, s_f = retention_scan(q, k, v, log_g[0], s0_fwd, True)
    o_b, s_b = retention_scan(flip_t(q), flip_t(k), flip_t(v), log_g[1], s0_bwd, False)
    return o_f + flip_t(o_b), s_f, s_b


def head_rms(o):
    o = o * lax.rsqrt(jnp.mean(o * o, axis=-1, keepdims=True) + NORM_EPS)
    return o.reshape(o.shape[0], o.shape[1], -1)


def token_shift(p, mu):
    prev = jnp.pad(p[:, :-1], ((0, 0), (1, 0), (0, 0)))
    nxt = jnp.pad(p[:, 1:], ((0, 0), (0, 1), (0, 0)))
    return p + mu[0] * (prev - p) + mu[1] * (nxt - p)


def rwkv_prepare(p, shift_mu, w0, w_up, a0, a_up, g_up, k_k, k_a):
    p = token_shift(p, shift_mu)
    w_ = RWKV_WIDTH
    r, k, v, wl, al, gl = jnp.split(
        p, [w_, 2 * w_, 3 * w_, 3 * w_ + DECAY_LORA, 3 * w_ + DECAY_LORA + AAA_LORA], axis=-1)
    kk = split_heads(k * k_k, RWKV_HEADS, RWKV_HEAD_DIM)
    kk = kk * lax.rsqrt(jnp.sum(kk * kk, axis=-1, keepdims=True) + 1e-12)
    dirs = []
    for d in range(2):
        w = jnp.exp(-W_DECAY_SCALE * jax.nn.sigmoid((w0[d] + jnp.tanh(wl) @ w_up[d]).astype(jnp.float32)))
        a = jax.nn.sigmoid((a0[d] + al @ a_up[d]).astype(jnp.float32))
        kt = k.astype(jnp.float32) * (1.0 + (a - 1.0) * k_a.astype(jnp.float32))
        dirs.append((split_heads(w, RWKV_HEADS, RWKV_HEAD_DIM),
                     split_heads(a, RWKV_HEADS, RWKV_HEAD_DIM),
                     split_heads(kt, RWKV_HEADS, RWKV_HEAD_DIM)))
    g = jax.nn.sigmoid(gl) @ g_up
    return (split_heads(r, RWKV_HEADS, RWKV_HEAD_DIM), split_heads(v, RWKV_HEADS, RWKV_HEAD_DIM), kk, dirs, g)


def rwkv7_scan(r, w, kk, a, kt, v, s0, inclusive):
    def update(state, w_t, kk_t, a_t, kt_t, v_t):
        removed = jnp.einsum('bhvk,bhk->bhv', state, kk_t)
        return (state * w_t[:, :, None, :]
                - removed[..., None] * (kk_t * a_t)[:, :, None, :]
                + v_t[..., None] * kt_t[:, :, None, :])

    def body(state, inp):
        r_t, w_t, kk_t, a_t, kt_t, v_t = inp
        if inclusive:
            state = update(state, w_t, kk_t, a_t, kt_t, v_t)
            y = jnp.einsum('bhvk,bhk->bhv', state, r_t)
        else:
            y = jnp.einsum('bhvk,bhk->bhv', state, r_t)
            state = update(state, w_t, kk_t, a_t, kt_t, v_t)
        return state, y

    xs = tuple(jnp.moveaxis(t, 1, 0) for t in (r, w, kk, a, kt, v))
    s_final, ys = lax.scan(body, s0, xs)
    return jnp.moveaxis(ys, 0, 1), s_final


def rwkv_bidir(r, v, kk, dirs, s0_fwd, s0_bwd):
    (w_f, a_f, kt_f), (w_b, a_b, kt_b) = dirs
    y_f, s_f = rwkv7_scan(r, w_f, kk, a_f, kt_f, v, s0_fwd, True)
    y_b, s_b = rwkv7_scan(flip_t(r), flip_t(w_b), flip_t(kk), flip_t(a_b), flip_t(kt_b), flip_t(v), s0_bwd, False)
    return y_f + flip_t(y_b), s_f, s_b


def merge_heads(o_ret, g_ret, y_rw, feat, r_k, ln_w, ln_b, w_out, dtype):
    r, v, _, dirs, g_rw = feat
    ret_out = head_rms(o_ret) * jax.nn.silu(g_ret.astype(jnp.float32))
    mean = jnp.mean(y_rw, axis=-1, keepdims=True)
    var = jnp.var(y_rw, axis=-1, keepdims=True)
    y_n = ((y_rw - mean) * lax.rsqrt(var + GN_EPS)).reshape(y_rw.shape[0], y_rw.shape[1], -1)
    y_n = y_n * ln_w.astype(jnp.float32) + ln_b.astype(jnp.float32)
    kt_f = dirs[0][2]
    rk = r_k.astype(jnp.float32).reshape(RWKV_HEADS, RWKV_HEAD_DIM)
    bonus = (jnp.sum(r * kt_f * rk, axis=-1, keepdims=True) * v).reshape(y_n.shape)
    rw_out = (y_n + bonus) * g_rw.astype(jnp.float32)
    return jnp.concatenate([ret_out, rw_out], axis=-1).astype(dtype) @ w_out


def token_mixers(hx, hc, rope, w_in, log_decay, shift_mu, w0, w_up, a0, a_up, g_up,
                 k_k, k_a, r_k, ln_w, ln_b, w_out, with_ctx_out):
    bsz = hx.shape[0]
    px = hx @ w_in
    pc = hc @ w_in

    log_g = -jnp.exp(log_decay.astype(jnp.float32))
    k_scale = RET_HEAD_DIM ** -0.5

    def ret_qkvg(p):
        q, k, v, g = jnp.split(p[..., :RET_COLS], 4, axis=-1)
        return (split_heads(q, RET_HEADS, RET_HEAD_DIM), split_heads(k, RET_HEADS, RET_HEAD_DIM) * k_scale,
                split_heads(v, RET_HEADS, RET_HEAD_DIM), g)

    qc, kc, vc, gc = ret_qkvg(pc)
    qx, kx, vx, gx = ret_qkvg(px)
    qx = apply_rope_2d(qx, rope)
    kx = apply_rope_2d(kx, rope)
    zeros_ret = jnp.zeros((bsz, RET_HEADS, RET_HEAD_DIM, RET_HEAD_DIM), jnp.float32)
    oc_ret, sf_ret, sb_ret = retention_bidir(qc, kc, vc, log_g, zeros_ret, zeros_ret)
    ox_ret, _, _ = retention_bidir(qx, kx, vx, log_g, sf_ret, sb_ret)

    feat_c = rwkv_prepare(pc[..., RET_COLS:], shift_mu, w0, w_up, a0, a_up, g_up, k_k, k_a)
    feat_x = rwkv_prepare(px[..., RET_COLS:], shift_mu, w0, w_up, a0, a_up, g_up, k_k, k_a)
    zeros_rw = jnp.zeros((bsz, RWKV_HEADS, RWKV_HEAD_DIM, RWKV_HEAD_DIM), jnp.float32)
    yc_rw, sf_rw, sb_rw = rwkv_bidir(feat_c[0], feat_c[1], feat_c[2], feat_c[3], zeros_rw, zeros_rw)
    yx_rw, _, _ = rwkv_bidir(feat_x[0], feat_x[1], feat_x[2], feat_x[3], sf_rw, sb_rw)

    out_x = merge_heads(ox_ret, gx, yx_rw, feat_x, r_k, ln_w, ln_b, w_out, hx.dtype)
    out_c = merge_heads(oc_ret, gc, yc_rw, feat_c, r_k, ln_w, ln_b, w_out, hc.dtype) if with_ctx_out else None
    return out_x, out_c


def squared_relu_mlp(h, w1, b1, w2, b2):
    return jnp.square(jax.nn.relu(h @ w1 + b1)) @ w2 + b2


def setup_inputs(seed: int = 0) -> dict:
    key = jax.random.key(seed)
    ks = jax.random.split(key, 32)
    L, D, W = DEPTH, D_MODEL, RWKV_WIDTH

    def nrm(k, shape, s):
        return jax.random.normal(k, shape, jnp.float32) * s

    base_decay = jnp.log(-jnp.log(1.0 - jnp.power(2.0, -5.0 - jnp.arange(RET_HEADS, dtype=jnp.float32))))
    return {
        'x': nrm(ks[0], (BATCH, SEQ, D), 1.0),
        'c': nrm(ks[1], (BATCH, D), 1.0),
        'ctx': nrm(ks[2], (BATCH, CTX_LEN, D), 1.0),
        'c_ctx': nrm(ks[3], (D,), 1.0),
        'w_ada': nrm(ks[4], (L, D, 6 * D), D ** -0.5),
        'b_ada': nrm(ks[5], (L, 6 * D), 0.02),
        'norm1_g': 1.0 + nrm(ks[6], (L, D), 0.02),
        'norm2_g': 1.0 + nrm(ks[7], (L, D), 0.02),
        'w_in': nrm(ks[8], (L, D, IN_COLS), D ** -0.5),
        'ret_log_decay': base_decay + nrm(ks[9], (L, 2, RET_HEADS), 0.05),
        'rwkv_shift_mu': jax.random.uniform(ks[10], (L, 2, SHIFT_COLS), jnp.float32, 0.0, 0.5),
        'rwkv_w0': jax.random.uniform(ks[11], (L, 2, W), jnp.float32, -3.0, 1.0),
        'rwkv_w_up': nrm(ks[12], (L, 2, DECAY_LORA, W), 0.5 * DECAY_LORA ** -0.5),
        'rwkv_a0': nrm(ks[13], (L, 2, W), 0.5),
        'rwkv_a_up': nrm(ks[14], (L, 2, AAA_LORA, W), 0.5 * AAA_LORA ** -0.5),
        'rwkv_g_up': nrm(ks[15], (L, GATE_LORA, W), GATE_LORA ** -0.5),
        'rwkv_k_k': 0.85 + nrm(ks[16], (L, W), 0.05),
        'rwkv_k_a': 1.0 + nrm(ks[17], (L, W), 0.05),
        'rwkv_r_k': nrm(ks[18], (L, W), 0.1),
        'rwkv_ln_w': 1.0 + nrm(ks[19], (L, W), 0.02),
        'rwkv_ln_b': nrm(ks[20], (L, W), 0.02),
        'w_out': nrm(ks[21], (L, D, D), D ** -0.5),
        'w_ff1': nrm(ks[22], (L, D, D_FF), D ** -0.5),
        'b_ff1': nrm(ks[23], (L, D_FF), 0.02),
        'w_ff2': nrm(ks[24], (L, D_FF, D), D_FF ** -0.5),
        'b_ff2': nrm(ks[25], (L, D), 0.02),
        'final_g': 1.0 + nrm(ks[26], (D,), 0.02),
    }


def reference(x, c, ctx, c_ctx, w_ada, b_ada, norm1_g, norm2_g, w_in, ret_log_decay,
              rwkv_shift_mu, rwkv_w0, rwkv_w_up, rwkv_a0, rwkv_a_up, rwkv_g_up,
              rwkv_k_k, rwkv_k_a, rwkv_r_k, rwkv_ln_w, rwkv_ln_b, w_out,
              w_ff1, b_ff1, w_ff2, b_ff2, final_g):
    n_tokens = x.shape[1]
    ROWS = n_tokens // GRID_W
    rows = jnp.repeat(jnp.arange(ROWS), GRID_W)
    cols = jnp.tile(jnp.arange(GRID_W), ROWS)
    rope = rope_tables(rows, cols)

    h_x, h_c = x, ctx
    for l in range(DEPTH):
        with_ctx = l < DEPTH - 1
        sh1, sc1, g1, sh2, sc2, g2 = [m[:, None, :] for m in adaln_params(c, w_ada[l], b_ada[l])]
        csh1, csc1, cg1, csh2, csc2, cg2 = adaln_params(c_ctx, w_ada[l], b_ada[l])
        nx = modulate(rmsnorm(h_x, norm1_g[l]), sh1, sc1)
        nc = modulate(rmsnorm(h_c, norm1_g[l]), csh1, csc1)
        mix_x, mix_c = token_mixers(nx, nc, rope, w_in[l], ret_log_decay[l], rwkv_shift_mu[l],
                                    rwkv_w0[l], rwkv_w_up[l], rwkv_a0[l], rwkv_a_up[l], rwkv_g_up[l],
                                    rwkv_k_k[l], rwkv_k_a[l], rwkv_r_k[l], rwkv_ln_w[l], rwkv_ln_b[l],
                                    w_out[l], with_ctx)
        h_x = h_x + g1 * mix_x
        h_x = h_x + g2 * squared_relu_mlp(modulate(rmsnorm(h_x, norm2_g[l]), sh2, sc2),
                                          w_ff1[l], b_ff1[l], w_ff2[l], b_ff2[l])
        if with_ctx:
            h_c = h_c + cg1 * mix_c
            h_c = h_c + cg2 * squared_relu_mlp(modulate(rmsnorm(h_c, norm2_g[l]), csh2, csc2),
                                              w_ff1[l], b_ff1[l], w_ff2[l], b_ff2[l])
    return rmsnorm(h_x, final_g)
```

```cpp
#include <hip/hip_runtime.h>
#include <hip/hip_cooperative_groups.h>
#include <cstdio>
#include <cstdint>
namespace cg = cooperative_groups;
namespace pg8 {
#define PG8_LAS __attribute__((address_space(3)))
typedef unsigned short bf16_t;
typedef short bf16x8 __attribute__((ext_vector_type(8)));
typedef float f32x4 __attribute__((ext_vector_type(4)));
typedef unsigned u32x4 __attribute__((ext_vector_type(4)));
constexpr int BM = 256, BK = 64, HALF = 128, HTB = HALF * BK * 2  , STAGE_BYTES = 8 * HTB, NXCD = 8, WGM = 8;

__host__ __device__ __forceinline__ int lds_byte(int r, int c) { const int st = (r >> 4) * 2 + (c >> 5), rr = r & 15, cc = c & 31, ob = rr * 64 + cc * 2; return st * 1024 + (ob ^ (((ob >> 9) & 1) << 5)); }
__host__ __device__ __forceinline__ void stage_rc(int b, int& R, int& C) { const int st = b / 1024, sb = b % 1024, swz = sb ^ (((sb >> 9) & 1) << 5); R = (st >> 1) * 16 + swz / 64; C = (st & 1) * 32 + (swz % 64) / 2; }
__host__ __device__ __forceinline__ int perm32(int rho) { const int n = rho >> 4, i = rho & 15; return 8 * (i >> 2) + 4 * n + (i & 3); }

struct Unit { int pm, pn; };
struct Gemm { const bf16_t* A; const bf16_t* Bt; int M, N, K; };

struct StaticOrder {
    int nM, nN, nwg, G, c;
    __host__ __device__ void init(int M, int N, int G_, int c_) { nM = M / BM; nN = N / BM; nwg = nM * nN; G = G_; c = c_; }
    __host__ __device__ bool next(int i, Unit& u) const {
        const long L = (long)i * G + c; if (L >= nwg) return false;
        int wgid = (int)L; { const int q = nwg / NXCD, r = nwg % NXCD, xcd = wgid % NXCD, off = wgid / NXCD; wgid = (xcd < r ? xcd * (q + 1) : r * (q + 1) + (xcd - r) * q) + off; }
        const int nig = WGM * nN, gid = wgid / nig, fm = gid * WGM, gsz = (nM - fm) < WGM ? (nM - fm) : WGM;
        u.pm = fm + ((wgid % nig) % gsz); u.pn = (wgid % nig) / gsz; return true;
    }
    __device__ __forceinline__ void a_ready(const Unit&) const {}
    __device__ __forceinline__ void done(const Unit&) const {}
};

__device__ __forceinline__ unsigned cvt_pk_bf16(float lo, float hi) { unsigned r; asm volatile("v_cvt_pk_bf16_f32 %0, %1, %2" : "=v"(r) : "v"(lo), "v"(hi)); return r; }

template <int ACT> struct EpiBf16 {
    static constexpr bool PERM = true, AFTER_DRAIN = false;
    bf16_t* O; int ldc; const float* bias;
    __device__ __forceinline__ void operator()(const f32x4 (&acc)[2][2][4][2], const Unit& u, int wr, int wc, int fr, int fq) const {
        const int row0 = u.pm * BM + wr * 64 + fr; const int col0 = u.pn * BM + wc * 32 + 8 * fq;
        f32x4 bv[2][2];
#pragma unroll
        for (int bj = 0; bj < 2; ++bj)
#pragma unroll
            for (int n = 0; n < 2; ++n) bv[bj][n] = bias ? *(const f32x4*)(bias + col0 + bj * HALF + 4 * n) : (f32x4){0.f, 0.f, 0.f, 0.f};
#pragma unroll
        for (int ai = 0; ai < 2; ++ai)
#pragma unroll
            for (int m = 0; m < 4; ++m) { bf16_t* rowp = O + (size_t)(row0 + ai * HALF + m * 16) * ldc + col0;
#pragma unroll
                for (int bj = 0; bj < 2; ++bj) { f32x4 v0 = acc[ai][bj][m][0] + bv[bj][0], v1 = acc[ai][bj][m][1] + bv[bj][1];
                    if (ACT == 2) {
#pragma unroll
                        for (int q = 0; q < 4; ++q) { float a = fmaxf(v0[q], 0.f), b = fmaxf(v1[q], 0.f); v0[q] = a * a; v1[q] = b * b; }
                    }
                    u32x4 w; w.x = cvt_pk_bf16(v0[0], v0[1]); w.y = cvt_pk_bf16(v0[2], v0[3]); w.z = cvt_pk_bf16(v1[0], v1[1]); w.w = cvt_pk_bf16(v1[2], v1[3]);
                    *(u32x4*)(rowp + bj * HALF) = w; } }
    }
};
typedef unsigned u32x2v __attribute__((ext_vector_type(2)));

struct EpiResidNorm {
    static constexpr bool PERM = false, AFTER_DRAIN = false;
    const float* base; float* out; int ldc; const float* gate; int gate_ld; int rows_per_gate; const float* ng; const float* sc2; bf16_t* a2; float* ss;
    __device__ __forceinline__ void operator()(const f32x4 (&acc)[2][2][4][2], const Unit& u, int wr, int wc, int fr, int fq) const {
        const int col0 = u.pn * BM + wc * 32 + 4 * fq;
        const size_t bofs = (size_t)((u.pm * BM) / rows_per_gate) * gate_ld;
        f32x4 gv[2][2], nv[2][2];
#pragma unroll
        for (int bj = 0; bj < 2; ++bj)
#pragma unroll
            for (int n = 0; n < 2; ++n) { const int c = col0 + bj * HALF + n * 16; gv[bj][n] = *(const f32x4*)(gate + bofs + c);
                nv[bj][n] = *(const f32x4*)(ng + c) * (*(const f32x4*)(sc2 + bofs + c) + 1.0f); }
#pragma unroll
        for (int ai = 0; ai < 2; ++ai)
#pragma unroll
            for (int m = 0; m < 4; ++m) { const int row = u.pm * BM + ai * HALF + wr * 64 + m * 16 + fr; const size_t off = (size_t)row * ldc + col0; float sq = 0.f;
#pragma unroll
                for (int bj = 0; bj < 2; ++bj)
#pragma unroll
                    for (int n = 0; n < 2; ++n) { const f32x4 h = __builtin_nontemporal_load((const f32x4*)(base + off + bj * HALF + n * 16)) + gv[bj][n] * acc[ai][bj][m][n];
                        *(f32x4*)(out + off + bj * HALF + n * 16) = h;
                        sq += (h[0] * h[0] + h[1] * h[1]) + (h[2] * h[2] + h[3] * h[3]);
                        const f32x4 a = h * nv[bj][n]; u32x2v w; w.x = cvt_pk_bf16(a[0], a[1]); w.y = cvt_pk_bf16(a[2], a[3]);
                        *(u32x2v*)(a2 + off + bj * HALF + n * 16) = w; }
                sq += __shfl_xor(sq, 16); sq += __shfl_xor(sq, 32);
                if (fq == 0) atomicAdd(ss + row, sq); }
    }
};
struct EpiBf16Row {
    static constexpr bool PERM = true, AFTER_DRAIN = false;
    bf16_t* O; int ldc; const float* cvec; int rows_per_b; const float* ss; float inv_k, eps;
    __device__ __forceinline__ void operator()(const f32x4 (&acc)[2][2][4][2], const Unit& u, int wr, int wc, int fr, int fq) const {
        const int row0 = u.pm * BM + wr * 64 + fr; const int col0 = u.pn * BM + wc * 32 + 8 * fq;
        const float* cp = cvec + (size_t)((u.pm * BM) / rows_per_b) * ldc;
        f32x4 bv[2][2];
#pragma unroll
        for (int bj = 0; bj < 2; ++bj)
#pragma unroll
            for (int n = 0; n < 2; ++n) bv[bj][n] = *(const f32x4*)(cp + col0 + bj * HALF + 4 * n);
#pragma unroll
        for (int ai = 0; ai < 2; ++ai)
#pragma unroll
            for (int m = 0; m < 4; ++m) { const int row = row0 + ai * HALF + m * 16; bf16_t* rowp = O + (size_t)row * ldc + col0;
                const float rs = __builtin_amdgcn_rsqf(ss[row] * inv_k + eps);
#pragma unroll
                for (int bj = 0; bj < 2; ++bj) { f32x4 v0 = acc[ai][bj][m][0] * rs + bv[bj][0], v1 = acc[ai][bj][m][1] * rs + bv[bj][1];
#pragma unroll
                    for (int q = 0; q < 4; ++q) { float a = fmaxf(v0[q], 0.f), b = fmaxf(v1[q], 0.f); v0[q] = a * a; v1[q] = b * b; }
                    u32x4 w; w.x = cvt_pk_bf16(v0[0], v0[1]); w.y = cvt_pk_bf16(v0[2], v0[3]); w.z = cvt_pk_bf16(v1[0], v1[1]); w.w = cvt_pk_bf16(v1[2], v1[3]);
                    *(u32x4*)(rowp + bj * HALF) = w; } }
    }
};

struct EpiResid {
    static constexpr bool PERM = false, AFTER_DRAIN = false;
    const float* base; float* out; int ldc; const float* bias; const float* gate; int gate_ld; int rows_per_gate;
    __device__ __forceinline__ void operator()(const f32x4 (&acc)[2][2][4][2], const Unit& u, int wr, int wc, int fr, int fq) const {
        const int col0 = u.pn * BM + wc * 32 + 4 * fq;
        const float* gp = gate + (size_t)((u.pm * BM) / rows_per_gate) * gate_ld;
        f32x4 gv[2][2], bv[2][2];
#pragma unroll
        for (int bj = 0; bj < 2; ++bj)
#pragma unroll
            for (int n = 0; n < 2; ++n) { gv[bj][n] = *(const f32x4*)(gp + col0 + bj * HALF + n * 16);
                bv[bj][n] = bias ? *(const f32x4*)(bias + col0 + bj * HALF + n * 16) : (f32x4){0.f, 0.f, 0.f, 0.f}; }
#pragma unroll
        for (int ai = 0; ai < 2; ++ai)
#pragma unroll
            for (int m = 0; m < 4; ++m) { const size_t off = (size_t)(u.pm * BM + ai * HALF + wr * 64 + m * 16 + fr) * ldc + col0;
#pragma unroll
                for (int bj = 0; bj < 2; ++bj)
#pragma unroll
                    for (int n = 0; n < 2; ++n) { const f32x4 bs = *(const f32x4*)(base + off + bj * HALF + n * 16);
                        *(f32x4*)(out + off + bj * HALF + n * 16) = bs + gv[bj][n] * (acc[ai][bj][m][n] + bv[bj][n]); } }
    }
};

template <class Epi, class Sched, bool ALIGN_EPI = false, bool SP2 = false>
__device__ __forceinline__ void gemm_phase(PG8_LAS unsigned char* lds, const Gemm g, const Sched& S, const Epi& E) {
    int tid_ = threadIdx.x; asm volatile("" : "+v"(tid_));
    const int tid = tid_, wid = __builtin_amdgcn_readfirstlane(tid >> 6), lane = tid & 63, wr = wid >> 2, wc = wid & 3, fr = lane & 15, fq = lane >> 4;
    const int K = g.K, nt = K / BK;
    unsigned voffA[2], voffB[2];
#pragma unroll
    for (int i = 0; i < 2; ++i) { int R, C; stage_rc(tid * 16 + i * 8192, R, C); const int Rb = Epi::PERM ? ((R & ~31) + perm32(R & 31)) : R;
        voffA[i] = (unsigned)(R * K + C) * 2u; voffB[i] = (unsigned)(Rb * K + C) * 2u; }
    const size_t kstep = (size_t)(BK * 2);
    const size_t hstep = (size_t)HALF * K * 2;
    const size_t tstep = 2 * hstep;
    const unsigned ldsw = (unsigned)wid * 1024u;
    const int aoff = lds_byte(wr * 64 + fr, fq * 8), boff = lds_byte(wc * 32 + fr, fq * 8);
#define PG8_SA(b, h) (((b) * 2 + (h)) * HTB)
#define PG8_SB(b, h) ((4 + (b) * 2 + (h)) * HTB)
#define PG8_STAGE(bufoff, gbase, voff) do { _Pragma("unroll") for (int _i = 0; _i < 2; ++_i) \
        __builtin_amdgcn_global_load_lds((const unsigned*)((const char*)(gbase) + (voff)[_i]), (PG8_LAS unsigned*)(lds + (bufoff) + ldsw + _i * 8192), 16, 0, 0); } while (0)
#define PG8_LDA(dst, b, h) do { _Pragma("unroll") for (int m = 0; m < 4; ++m) _Pragma("unroll") for (int k = 0; k < 2; ++k) dst[m][k] = *(const PG8_LAS bf16x8*)(lds + PG8_SA(b, h) + aoff + m * 2048 + k * 1024); } while (0)
#define PG8_LDB(dst, b, h) do { _Pragma("unroll") for (int n = 0; n < 2; ++n) _Pragma("unroll") for (int k = 0; k < 2; ++k) dst[n][k] = *(const PG8_LAS bf16x8*)(lds + PG8_SB(b, h) + boff + n * 2048 + k * 1024); } while (0)
#define PG8_MMA(ai, bj, At, Bt) do { __builtin_amdgcn_s_setprio(1); _Pragma("unroll") for (int m = 0; m < 4; ++m) _Pragma("unroll") for (int n = 0; n < 2; ++n) _Pragma("unroll") for (int k = 0; k < 2; ++k) \
        acc[ai][bj][m][n] = __builtin_amdgcn_mfma_f32_16x16x32_bf16(Bt[n][k], At[m][k], acc[ai][bj][m][n], 0, 0, 0); __builtin_amdgcn_s_setprio(0); } while (0)
#define PG8_WAIT_V(n) asm volatile("s_waitcnt vmcnt(" #n ")" ::: "memory")
#define PG8_WAIT_L(n) asm volatile("s_waitcnt lgkmcnt(" #n ")" ::: "memory")
#define PG8_BAR __builtin_amdgcn_s_barrier()
#define PG8_SCHED __builtin_amdgcn_sched_barrier(0)
    Unit cur, nxt; int ui = 0;
    if (!S.next(0, cur)) return;
    f32x4 acc[2][2][4][2];
#pragma unroll
    for (int a = 0; a < 2; ++a)
#pragma unroll
        for (int b = 0; b < 2; ++b)
#pragma unroll
            for (int m = 0; m < 4; ++m)
#pragma unroll
                for (int n = 0; n < 2; ++n) acc[a][b][m][n] = (f32x4){0.f, 0.f, 0.f, 0.f};
    bf16x8 At[4][2], B0[2][2], B1[2][2];
    const char* cA = (const char*)g.A + (size_t)cur.pm * tstep; const char* cB = (const char*)g.Bt + (size_t)cur.pn * tstep;
    S.a_ready(cur);
    if constexpr (SP2) {
        PG8_STAGE(PG8_SB(0, 0), cB, voffB); PG8_STAGE(PG8_SB(0, 1), cB + hstep, voffB); PG8_STAGE(PG8_SA(0, 0), cA, voffA); PG8_STAGE(PG8_SA(0, 1), cA + hstep, voffA);
        if (wr == 1) PG8_BAR;
        PG8_WAIT_V(2); PG8_BAR;
        PG8_STAGE(PG8_SB(1, 0), cB + kstep, voffB); PG8_STAGE(PG8_SA(1, 0), cA + kstep, voffA); PG8_STAGE(PG8_SB(1, 1), cB + hstep + kstep, voffB);
        PG8_WAIT_V(6); PG8_BAR;
    } else {
        PG8_STAGE(PG8_SB(0, 0), cB, voffB); PG8_STAGE(PG8_SA(0, 0), cA, voffA); PG8_STAGE(PG8_SB(0, 1), cB + hstep, voffB); PG8_STAGE(PG8_SA(0, 1), cA + hstep, voffA);
        if (wr == 1) PG8_BAR;
        PG8_WAIT_V(4); PG8_BAR;
        PG8_STAGE(PG8_SB(1, 0), cB + kstep, voffB); PG8_STAGE(PG8_SA(1, 0), cA + kstep, voffA); PG8_STAGE(PG8_SB(1, 1), cB + hstep + kstep, voffB);
        PG8_WAIT_V(6); PG8_BAR;
    }
    for (;;) {
        const bool has_next = S.next(ui + 1, nxt);
        const char* nA = has_next ? (const char*)g.A + (size_t)nxt.pm * tstep : cA; const char* nB = has_next ? (const char*)g.Bt + (size_t)nxt.pn * tstep : cB;
        for (int t = 0; t < nt; t += 2) {
            const bool last = (t == nt - 2);
            const char* a1 = cA + (size_t)(t + 1) * kstep;
            const char* a2 = last ? nA : cA + (size_t)(t + 2) * kstep; const char* b2 = last ? nB : cB + (size_t)(t + 2) * kstep;
            const char* a3 = a2 + kstep; const char* b3 = b2 + kstep;
            if (last && has_next) S.a_ready(nxt);
            if constexpr (SP2) {
            PG8_LDB(B0, 0, 0); PG8_LDB(B1, 0, 1); PG8_SCHED; PG8_LDA(At, 0, 0); PG8_STAGE(PG8_SA(1, 1), a1 + hstep, voffA);
            PG8_WAIT_V(8); PG8_WAIT_L(0); PG8_BAR; PG8_MMA(0, 0, At, B0); PG8_MMA(0, 1, At, B1); PG8_BAR; PG8_SCHED;
            PG8_LDA(At, 0, 1); PG8_STAGE(PG8_SB(0, 0), b2, voffB); PG8_STAGE(PG8_SB(0, 1), b2 + hstep, voffB); PG8_STAGE(PG8_SA(0, 0), a2, voffA);
            PG8_WAIT_V(8); PG8_WAIT_L(0); PG8_BAR; PG8_MMA(1, 0, At, B0); PG8_MMA(1, 1, At, B1); PG8_BAR; PG8_SCHED;
            PG8_LDB(B0, 1, 0); PG8_LDB(B1, 1, 1); PG8_SCHED; PG8_LDA(At, 1, 0); PG8_STAGE(PG8_SA(0, 1), a2 + hstep, voffA);
            PG8_WAIT_V(8); PG8_WAIT_L(0); PG8_BAR; PG8_MMA(0, 0, At, B0); PG8_MMA(0, 1, At, B1); PG8_BAR; PG8_SCHED;
            PG8_LDA(At, 1, 1); PG8_STAGE(PG8_SB(1, 0), b3, voffB); PG8_STAGE(PG8_SB(1, 1), b3 + hstep, voffB); PG8_STAGE(PG8_SA(1, 0), a3, voffA);
            PG8_WAIT_V(8); PG8_WAIT_L(0); PG8_BAR; PG8_MMA(1, 0, At, B0); PG8_MMA(1, 1, At, B1); PG8_BAR; PG8_SCHED;
            } else {
            PG8_LDB(B0, 0, 0); PG8_SCHED; PG8_LDA(At, 0, 0); PG8_STAGE(PG8_SA(1, 1), a1 + hstep, voffA);
            PG8_WAIT_L(8); PG8_BAR; PG8_WAIT_L(0); PG8_MMA(0, 0, At, B0); PG8_BAR; PG8_SCHED;
            PG8_LDB(B1, 0, 1); PG8_STAGE(PG8_SB(0, 0), b2, voffB);
            PG8_BAR; PG8_WAIT_L(0); PG8_MMA(0, 1, At, B1); PG8_BAR;
            PG8_LDA(At, 0, 1); PG8_STAGE(PG8_SA(0, 0), a2, voffA);
            PG8_BAR; PG8_WAIT_L(0); PG8_MMA(1, 0, At, B0); PG8_BAR; PG8_SCHED;
            PG8_STAGE(PG8_SB(0, 1), b2 + hstep, voffB);
            PG8_WAIT_V(6); PG8_BAR; PG8_MMA(1, 1, At, B1); PG8_BAR;
            PG8_LDB(B0, 1, 0); PG8_SCHED; PG8_LDA(At, 1, 0); PG8_STAGE(PG8_SA(0, 1), a2 + hstep, voffA);
            PG8_WAIT_L(8); PG8_BAR; PG8_WAIT_L(0); PG8_MMA(0, 0, At, B0); PG8_BAR; PG8_SCHED;
            PG8_LDB(B1, 1, 1); PG8_STAGE(PG8_SB(1, 0), b3, voffB);
            PG8_BAR; PG8_WAIT_L(0); PG8_MMA(0, 1, At, B1); PG8_BAR;
            PG8_LDA(At, 1, 1); PG8_STAGE(PG8_SA(1, 0), a3, voffA);
            PG8_BAR; PG8_WAIT_L(0); PG8_MMA(1, 0, At, B0); PG8_BAR; PG8_SCHED;
            PG8_STAGE(PG8_SB(1, 1), b3 + hstep, voffB);
            PG8_WAIT_V(6); PG8_BAR; PG8_MMA(1, 1, At, B1); PG8_BAR;
            }
        }
        if constexpr (ALIGN_EPI) { if (wr == 0) PG8_BAR; }
        if constexpr (!Epi::AFTER_DRAIN) { E(acc, cur, wr, wc, fr, fq); S.done(cur); }
        if (!has_next) break;
#pragma unroll
        for (int a = 0; a < 2; ++a)
#pragma unroll
            for (int b = 0; b < 2; ++b)
#pragma unroll
                for (int m = 0; m < 4; ++m)
#pragma unroll
                    for (int n = 0; n < 2; ++n) acc[a][b][m][n] = (f32x4){0.f, 0.f, 0.f, 0.f};
        cur = nxt; cA = nA; cB = nB; ++ui;
        if constexpr (ALIGN_EPI) { if (wr == 1) PG8_BAR; }
    }
    PG8_WAIT_V(0);
    if constexpr (!ALIGN_EPI) { if (wr == 0) PG8_BAR; }
    PG8_BAR;
    if constexpr (Epi::AFTER_DRAIN) { E.fused(acc, cur, wr, wc, fr, fq, lds, wid, lane); S.done(cur); }
#undef PG8_SA
#undef PG8_SB
#undef PG8_STAGE
#undef PG8_LDA
#undef PG8_LDB
#undef PG8_MMA
#undef PG8_WAIT_V
#undef PG8_WAIT_L
#undef PG8_BAR
#undef PG8_SCHED
}
}

constexpr int NB = 16, SEQ = 2048, CTXL = 256, DM = 1024, DFF = 4096;
constexpr int NX = NB * SEQ, NC = NB * CTXL, NTOK = NX + NC;
constexpr int INC = 3840;
constexpr int C_RQ = 0, C_RK = 512, C_RV = 1024, C_RG = 1536;
constexpr int C_WR = 2048, C_WK = 2560, C_WV = 3072, C_WL = 3584, C_AL = 3648, C_GL = 3712;
constexpr int ADA_LD = 6 * DM;
constexpr int NWAVES = 8;
constexpr size_t MiB = 1u << 20;
constexpr size_t WS_CTL = 0;
constexpr size_t WS_ADA = 1 * MiB;
constexpr size_t WS_ROPE = 1 * MiB + 512 * 1024;
constexpr size_t WS_SS = 256 * 1024;
constexpr size_t WS_CMAT = 30 * MiB;
constexpr size_t WS_BONUS = 2 * MiB;
constexpr size_t WS_GUPT = 3 * MiB;
constexpr size_t WS_WIN = 4 * MiB, WS_WOUT = 12 * MiB, WS_W1 = 14 * MiB, WS_W2 = 22 * MiB;
constexpr size_t WS_P = 32 * MiB;
constexpr size_t WS_XN = 304 * MiB;
constexpr size_t WS_YF = 304 * MiB, WS_YB = 336 * MiB;
constexpr size_t WS_MIXA = 376 * MiB;
constexpr size_t WS_OF = 440 * MiB, WS_OB = 472 * MiB;
constexpr size_t WS_XN2 = 440 * MiB;
constexpr size_t WS_END = 504 * MiB;
constexpr int LDS_BYTES = 155648;

typedef unsigned short bf16;
typedef unsigned v4u __attribute__((ext_vector_type(4)));
typedef unsigned v2u __attribute__((ext_vector_type(2)));
typedef float f32x4 __attribute__((ext_vector_type(4)));
typedef float f32x2 __attribute__((ext_vector_type(2)));
typedef short bf16x8 __attribute__((ext_vector_type(8)));

typedef __bf16 bf2_t __attribute__((ext_vector_type(2)));
__device__ __forceinline__ unsigned cvt2bf(float a, float b) { const f32x2 v = {a, b}; return __builtin_bit_cast(unsigned, __builtin_convertvector(v, bf2_t)); }
__device__ __forceinline__ unsigned f2bf(float f) { return cvt2bf(f, 0.f) & 0xffffu; }
__device__ __forceinline__ unsigned pk2(float lo, float hi) { return cvt2bf(lo, hi); }
__device__ __forceinline__ float bflo(unsigned u) { return __builtin_bit_cast(float, u << 16); }
__device__ __forceinline__ float bfhi(unsigned u) { return __builtin_bit_cast(float, u & 0xffff0000u); }
__device__ __forceinline__ void unpack8(const v4u w, float (&f)[8]) { f[0] = bflo(w.x); f[1] = bfhi(w.x); f[2] = bflo(w.y); f[3] = bfhi(w.y); f[4] = bflo(w.z); f[5] = bfhi(w.z); f[6] = bflo(w.w); f[7] = bfhi(w.w); }
__device__ __forceinline__ v4u pack8(const float (&f)[8]) { v4u w; w.x = pk2(f[0], f[1]); w.y = pk2(f[2], f[3]); w.z = pk2(f[4], f[5]); w.w = pk2(f[6], f[7]); return w; }
__device__ __forceinline__ void ld8f(const float* p, float (&f)[8]) { const f32x4 a = *(const f32x4*)p, b = *(const f32x4*)(p + 4); f[0] = a.x; f[1] = a.y; f[2] = a.z; f[3] = a.w; f[4] = b.x; f[5] = b.y; f[6] = b.z; f[7] = b.w; }
__device__ __forceinline__ float sigmoidf_(float x) { return __builtin_amdgcn_rcpf(1.f + __expf(-x)); }
template <int CTRL> __device__ __forceinline__ float dpp_mov(float x) { return __builtin_bit_cast(float, __builtin_amdgcn_update_dpp(0, __builtin_bit_cast(int, x), CTRL, 0xf, 0xf, false)); }
__device__ __forceinline__ float red8(float x) { x += dpp_mov<0xB1>(x); x += dpp_mov<0x4E>(x); x += dpp_mov<0x141>(x); return x; }
__device__ __forceinline__ float red16(float x) { x = red8(x); x += dpp_mov<0x128>(x); return x; }
__device__ __forceinline__ float wave_sum(float v) {
#pragma unroll
    for (int o = 1; o < 64; o <<= 1) v += __shfl_xor(v, o);
    return v;
}
__device__ __forceinline__ bf16x8 ldfrag(const unsigned char* base, int stride_bytes, int row0, int k0, int lane) {
    return *(const bf16x8*)(base + (row0 + (lane & 15)) * stride_bytes + (k0 + (lane >> 4) * 8) * 2);
}
#define MFMA16(a, b, c) __builtin_amdgcn_mfma_f32_16x16x32_bf16((a), (b), (c), 0, 0, 0)

struct Frame {
    unsigned char* lds;
    int tid, lane, wave, G, bid;
    const float* in[27];
    float* out; unsigned char* ws;
};

__device__ __forceinline__ void p0_transpose_item(const float* W, int K, int N, bf16* WT, float* scr, int item, int lane) {
    const int nblk = N / 32, kb = item / nblk, nb = item % nblk, k0 = 64 * kb, n0 = 32 * nb;
#pragma unroll 8
    for (int i = 0; i < 32; ++i) { const int kk = 2 * i + (lane >> 5); scr[kk * 33 + (lane & 31)] = W[(size_t)(k0 + kk) * N + n0 + (lane & 31)]; }
    asm volatile("s_waitcnt lgkmcnt(0)" ::: "memory");
    const int c = lane & 7;
#pragma unroll
    for (int j = 0; j < 4; ++j) { const int n = (lane >> 3) + 8 * j; const float* s = scr + (8 * c) * 33 + n;
        v4u o; o.x = pk2(s[0 * 33], s[1 * 33]); o.y = pk2(s[2 * 33], s[3 * 33]); o.z = pk2(s[4 * 33], s[5 * 33]); o.w = pk2(s[6 * 33], s[7 * 33]);
        *(v4u*)(WT + (size_t)(n0 + n) * K + k0 + 8 * c) = o; }
    asm volatile("s_waitcnt lgkmcnt(0)" ::: "memory");
}
__device__ __forceinline__ void p0_phase(Frame& F) {
    float* cs = (float*)F.lds;
    float* red = (float*)(F.lds + 71680);
    const float* c = F.in[1]; const float* c_ctx = F.in[3]; const float* w_ada = F.in[4]; const float* b_ada = F.in[5];
    float* ADA = (float*)(F.ws + WS_ADA);
    bool staged = false;
    for (int cb = F.bid; cb < 192; cb += F.G) {
        if (!staged) {
            for (int idx = F.tid; idx < 17 * 1024; idx += 512) { const int r = idx >> 10, k = idx & 1023; const float v = (r < 16) ? c[r * 1024 + k] : c_ctx[k]; cs[idx] = v / (1.f + __expf(-v)); }
            staged = true;
        }
        __syncthreads();
        const int col = F.tid & 31, kp = F.tid >> 5;
        float acc[17];
#pragma unroll
        for (int r = 0; r < 17; ++r) acc[r] = 0.f;
        const float* wp = w_ada + (size_t)(kp * 64) * ADA_LD + cb * 32 + col;
#pragma unroll 4
        for (int kk = 0; kk < 64; ++kk) { const float w = wp[(size_t)kk * ADA_LD]; const int k = kp * 64 + kk;
#pragma unroll
            for (int r = 0; r < 17; ++r) acc[r] += cs[r * 1024 + k] * w; }
#pragma unroll
        for (int r = 0; r < 17; ++r) red[(kp * 17 + r) * 32 + col] = acc[r];
        __syncthreads();
        for (int idx = F.tid; idx < 17 * 32; idx += 512) { const int r = idx >> 5, cc = idx & 31; float s = 0.f;
#pragma unroll
            for (int q = 0; q < 16; ++q) s += red[(q * 17 + r) * 32 + cc];
            ADA[r * ADA_LD + cb * 32 + cc] = s + b_ada[cb * 32 + cc]; }
    }
    __syncthreads();
    if (F.bid == F.G - 1) {
        float* rc = (float*)(F.ws + WS_ROPE); float* rs = rc + 2048;
        for (int idx = F.tid; idx < 2048; idx += 512) { const int pos = idx >> 5, f = idx & 31;
            const float inv = exp2f(-(float)(2 * f) * (13.287712379549449f / 64.f));
            const float ang = (float)pos * inv; float rev = ang * 0.15915494309189535f; rev = rev - floorf(rev);
            rc[idx] = __builtin_amdgcn_cosf(rev); rs[idx] = __builtin_amdgcn_sinf(rev); }
    }
    float* scr = (float*)(F.lds + F.wave * 16384);
    const int gw = F.bid * NWAVES + F.wave, NGW = F.G * NWAVES;
    constexpr int I_IN = (DM / 64) * (INC / 32), I_OUT = (DM / 64) * (DM / 32), I_1 = (DM / 64) * (DFF / 32), I_2 = (DFF / 64) * (DM / 32), I_G = (128 / 64) * (512 / 32);
    (void)I_OUT; (void)I_1; (void)I_2;
    for (int it = gw; it < I_IN + I_G; it += NGW) {
        if (it < I_IN) p0_transpose_item(F.in[8], DM, INC, (bf16*)(F.ws + WS_WIN), scr, it, F.lane);
        else p0_transpose_item(F.in[15], 128, 512, (bf16*)(F.ws + WS_GUPT), scr, it - I_IN, F.lane);
    }
}
__device__ __forceinline__ void wconv_tail(Frame& F, int first_bid) {
    if (F.bid < first_bid) return;
    float* scr = (float*)(F.lds + F.wave * 16384);
    const int gw = (F.bid - first_bid) * NWAVES + F.wave, NGW = (F.G - first_bid) * NWAVES;
    constexpr int I_OUT = (DM / 64) * (DM / 32), I_1 = (DM / 64) * (DFF / 32), I_2 = (DFF / 64) * (DM / 32);
    for (int it = gw; it < I_OUT + I_1 + I_2; it += NGW) {
        int r = it;
        if (r < I_OUT) { p0_transpose_item(F.in[21], DM, DM, (bf16*)(F.ws + WS_WOUT), scr, r, F.lane); continue; } r -= I_OUT;
        if (r < I_1) { p0_transpose_item(F.in[22], DM, DFF, (bf16*)(F.ws + WS_W1), scr, r, F.lane); continue; } r -= I_1;
        p0_transpose_item(F.in[24], DFF, DM, (bf16*)(F.ws + WS_W2), scr, r, F.lane);
    }
}

template <int MODE> __device__ __forceinline__ void norm_phase(Frame& F) {
    const int gw = F.bid * NWAVES + F.wave, NGW = F.G * NWAVES;
    const float* ADA = (const float*)(F.ws + WS_ADA);
    const float* gam = MODE == 0 ? F.in[6] : (MODE == 1 ? F.in[7] : F.in[26]);
    const int nrows = MODE == 0 ? NTOK : NX;
    f32x4 g4[4];
#pragma unroll
    for (int j = 0; j < 4; ++j) g4[j] = *(const f32x4*)(gam + j * 256 + F.lane * 4);
    const int per = (nrows + NGW - 1) / NGW, m_end = (gw + 1) * per < nrows ? (gw + 1) * per : nrows;
    int bcur = -1; f32x4 sg[4], sh[4];
    for (int m = gw * per; m < m_end; ++m) {
        const float* src; int b;
        if (MODE == 0) { if (m < NX) { src = F.in[0] + (size_t)m * DM; b = m >> 11; } else { src = F.in[2] + (size_t)(m - NX) * DM; b = 16; } }
        else { src = F.out + (size_t)m * DM; b = m >> 11; }
        f32x4 v[4]; float s = 0.f;
#pragma unroll
        for (int j = 0; j < 4; ++j) { v[j] = __builtin_nontemporal_load((const f32x4*)(src + j * 256 + F.lane * 4)); s += (v[j].x * v[j].x + v[j].y * v[j].y) + (v[j].z * v[j].z + v[j].w * v[j].w); }
        if (MODE != 2 && b != bcur) {
            const float* ar = ADA + (size_t)b * ADA_LD + (MODE == 0 ? 0 : 3 * DM); bcur = b;
#pragma unroll
            for (int j = 0; j < 4; ++j) { const int col = j * 256 + F.lane * 4; sh[j] = *(const f32x4*)(ar + col); sg[j] = g4[j] * (*(const f32x4*)(ar + DM + col) + 1.0f); }
        }
        const float rs = 1.0f / sqrtf(wave_sum(s) * (1.f / DM) + 1e-6f);
        if (MODE == 2) {
#pragma unroll
            for (int j = 0; j < 4; ++j) __builtin_nontemporal_store(v[j] * rs * g4[j], (f32x4*)(F.out + (size_t)m * DM + j * 256 + F.lane * 4));
        } else {
            bf16* dst = (bf16*)(F.ws + (MODE == 0 ? WS_XN : WS_XN2)) + (size_t)m * DM;
#pragma unroll
            for (int j = 0; j < 4; ++j) { const int col = j * 256 + F.lane * 4;
                const f32x4 y = v[j] * rs * sg[j] + sh[j];
                v2u o; o.x = pk2(y.x, y.y); o.y = pk2(y.z, y.w); *(v2u*)(dst + col) = o; }
        }
    }
}

__device__ __forceinline__ void cmat_phase(Frame& F, int first_bid) {
    if (F.bid < first_bid) return;
    const int vb = F.bid - first_bid, VG = F.G - first_bid;
    float* cs = (float*)F.lds;
    float* red = (float*)(F.lds + 65536);
    const float* ADA = (const float*)(F.ws + WS_ADA); const float* w1 = F.in[22]; const float* b1 = F.in[23];
    float* CM = (float*)(F.ws + WS_CMAT);
    bool staged = false;
    for (int cb = vb; cb < 128; cb += VG) {
        if (!staged) { for (int idx = F.tid; idx < 16 * 1024; idx += 512) cs[idx] = ADA[(size_t)(idx >> 10) * ADA_LD + 3 * DM + (idx & 1023)]; staged = true; }
        __syncthreads();
        const int col = F.tid & 31, kp = F.tid >> 5;
        float acc[16];
#pragma unroll
        for (int r = 0; r < 16; ++r) acc[r] = 0.f;
        const float* wp = w1 + (size_t)(kp * 64) * DFF + cb * 32 + col;
#pragma unroll 4
        for (int kk = 0; kk < 64; ++kk) { const float w = wp[(size_t)kk * DFF]; const int k = kp * 64 + kk;
#pragma unroll
            for (int r = 0; r < 16; ++r) acc[r] += cs[r * 1024 + k] * w; }
#pragma unroll
        for (int r = 0; r < 16; ++r) red[(kp * 16 + r) * 32 + col] = acc[r];
        __syncthreads();
        { const int r = F.tid >> 5, cc = F.tid & 31; float s = 0.f;
#pragma unroll
          for (int q = 0; q < 16; ++q) s += red[(q * 16 + r) * 32 + cc];
          CM[r * DFF + cb * 32 + cc] = s + b1[cb * 32 + cc]; }
    }
    __syncthreads();
}

constexpr int RWC = 32;
constexpr int RW_W = 0, RW_B = 8192, RW_KT = 16384, RW_KKI = 24576, RW_RI = 28672, RW_R = 32768, RW_V = 40960, RW_BUF = 49152;
constexpr int RW_Y = 98304, RW_A = 114688, RW_UP = 123904, RW_PAR = RW_UP + 18432 + 768;
constexpr int RW_TSTRIDE = 144;
constexpr int RW_PCNT = RW_UP + 18432 + 768 + 2816 + 8704;
constexpr int RW_ZERO = RW_UP + 18432 + 768 + 2816;
__device__ __forceinline__ int rw_perm(int k) { const int t = k >> 4, g = (k >> 2) & 3, j = k & 3; return (t >> 1) * 32 + g * 8 + (t & 1) * 4 + j; }
struct RwPos { int woff, bkoff, voff, ap, yo; };
struct RwOps { v4u A2[4]; f32x4 w[4]; float v; };
__device__ __forceinline__ void rw_ld_ops(const unsigned char* L, const RwPos& P, RwOps& o) {
#pragma unroll
    for (int t = 0; t < 4; ++t) { o.w[t] = *(const f32x4*)(L + P.woff + t * 64); o.A2[t].x = *(const unsigned*)(L + P.bkoff + t * 64); }
    o.v = *(const float*)(L + P.voff);
}
__device__ __forceinline__ void rw_update(f32x4 (&St)[4], RwOps& o, v4u& B2, const float rem) {
    B2.x = cvt2bf(rem, o.v);
    asm("" : "+v"(B2));
#pragma unroll
    for (int t = 0; t < 4; ++t) asm("" : "+v"(o.A2[t]));
#pragma unroll
    for (int t = 0; t < 4; ++t) St[t] = MFMA16(__builtin_bit_cast(bf16x8, o.A2[t]), __builtin_bit_cast(bf16x8, B2), St[t] * o.w[t]);
}
__device__ __forceinline__ f32x4 rw_readout(const f32x4 (&St)[4], const bf16x8 a0, const bf16x8 a1) {
    v4u b0, b1;
    b0.x = cvt2bf(St[0].x, St[0].y); b0.y = cvt2bf(St[0].z, St[0].w); b0.z = cvt2bf(St[1].x, St[1].y); b0.w = cvt2bf(St[1].z, St[1].w);
    b1.x = cvt2bf(St[2].x, St[2].y); b1.y = cvt2bf(St[2].z, St[2].w); b1.z = cvt2bf(St[3].x, St[3].y); b1.w = cvt2bf(St[3].z, St[3].w);
    f32x4 acc = {0.f, 0.f, 0.f, 0.f};
    acc = MFMA16(a0, __builtin_bit_cast(bf16x8, b0), acc);
    acc = MFMA16(a1, __builtin_bit_cast(bf16x8, b1), acc);
    return acc;
}
template <bool INCL, bool WY> __device__ __forceinline__ void rw_scan_chunk(const unsigned char* Lin, const unsigned char* L, unsigned char* Ly, f32x4 (&St)[4], int wave, int lane) {
    const int n = lane & 15, g = lane >> 4, sel = lane & 3, lin = (int)(Lin - L), row = wave * 16 + n;
    const bool g0 = g == 0;
    RwPos P; P.woff = lin + RW_W + g * 16; P.bkoff = g0 ? lin + RW_B + n * 4 : RW_ZERO; P.voff = lin + RW_V + row * 4; P.yo = (int)(Ly - L) + row * 4;
    P.ap = sel == 0 ? lin + RW_KKI + g * 16 + (INCL ? 128 : 0) : (sel == 1 ? lin + RW_RI + g * 16 : RW_ZERO);
    constexpr int astep = 128, bkstep = 256;
    unsigned char* Lw = const_cast<unsigned char*>(L);
    RwOps O;
#pragma unroll
    for (int t = 0; t < 4; ++t) O.A2[t] = (v4u){0u, 0u, 0u, 0u};
    v4u B2 = {0u, 0u, 0u, 0u};
    float rem = 0.f;
    if (INCL) { const int f0p = P.ap - astep; rem = rw_readout(St, *(const bf16x8*)(L + f0p), *(const bf16x8*)(L + f0p + 64))[0]; }
    rw_ld_ops(L, P, O);
    bf16x8 ca0 = *(const bf16x8*)(L + P.ap), ca1 = *(const bf16x8*)(L + P.ap + 64);
#pragma unroll 4
    for (int i = 0; i < RWC; ++i) {
        P.woff += 256; P.bkoff += bkstep; P.voff += 256; P.ap += astep;
        float y;
        if (INCL) {
            rw_update(St, O, B2, rem);
            asm volatile("" ::: "memory");
            rw_ld_ops(L, P, O);
            const bf16x8 na0 = *(const bf16x8*)(L + P.ap), na1 = *(const bf16x8*)(L + P.ap + 64);
            const f32x4 acc = rw_readout(St, ca0, ca1); rem = acc[0]; y = acc[1];
            ca0 = na0; ca1 = na1;
        } else {
            const f32x4 acc = rw_readout(St, ca0, ca1); y = acc[1];
            ca0 = *(const bf16x8*)(L + P.ap); ca1 = *(const bf16x8*)(L + P.ap + 64);
            asm volatile("" ::: "memory");
            rw_update(St, O, B2, acc[0]);
            asm volatile("" ::: "memory");
            rw_ld_ops(L, P, O);
        }
        if (WY) { *(float*)(Lw + P.yo) = y; P.yo += 256; }
    }
}
__device__ __forceinline__ void rw_mfma_part(unsigned char* L, unsigned char* Lb, int wave, int lane) {
    const int mat = wave >> 2, nt = wave & 3, ecol = nt * 16 + (lane & 15);
    const unsigned char* LUP = L + RW_UP + mat * 9216;
    const bf16x8 bf0 = ldfrag(LUP, RW_TSTRIDE, nt * 16, 0, lane), bf1 = ldfrag(LUP, RW_TSTRIDE, nt * 16, 32, lane);
    const float bias0 = ((const float*)(L + RW_UP + 18432))[mat * 64 + ecol], kav = ((const float*)(L + RW_UP + 18432))[128 + ecol];
#pragma unroll
    for (int mt = 0; mt < 2; ++mt) {
        const unsigned char* A = L + RW_A + (mat * 2 + mt) * 2304;
        f32x4 acc = {0.f, 0.f, 0.f, 0.f};
        acc = MFMA16(ldfrag(A, RW_TSTRIDE, 0, 0, lane), bf0, acc);
        acc = MFMA16(ldfrag(A, RW_TSTRIDE, 0, 32, lane), bf1, acc);
#pragma unroll
        for (int j = 0; j < 4; ++j) { const int row = mt * 16 + (lane >> 4) * 4 + j; const int o4 = (row * 64 + ecol) * 4; const float z = acc[j] + bias0;
            if (mat == 0) { *(float*)(Lb + RW_W + o4) = __expf(-0.6065306597126334f * sigmoidf_(z)); }
            else { const float a = sigmoidf_(z); const float bv_ = bflo((unsigned)*(const bf16*)(Lb + RW_KKI + row * 128 + rw_perm(ecol) * 2)) * a;
                   const float kt_ = *(const float*)(Lb + RW_KT + o4) * (1.f + (a - 1.f) * kav);
                   *(float*)(Lb + RW_KT + o4) = kt_; *(unsigned*)(Lb + RW_B + o4) = pg8::cvt_pk_bf16(-bv_, kt_); } }
    }
}
__device__ __forceinline__ void rwkv_scan_unit(Frame& F, int sid) {
    asm volatile("" : "+v"(F.tid)); F.lane = F.tid & 63;
    const int b = sid >> 4, h = (sid >> 1) & 7, d = sid & 1, hc = h * 64;
    unsigned char* L = F.lds;
    constexpr int NCC = CTXL / RWC, NCH = NCC + SEQ / RWC;
#pragma unroll 4
    for (int q = 0; q < 16; ++q) { const int idx = F.tid + 512 * q; const int m_ = idx >> 12, k_ = (idx >> 6) & 63, n_ = idx & 63;
        *(bf16*)(L + RW_UP + m_ * 9216 + n_ * RW_TSTRIDE + k_ * 2) = (bf16)f2bf((m_ == 0 ? F.in[12] : F.in[14])[(size_t)d * 64 * 512 + (size_t)k_ * 512 + hc + n_]); }
#pragma unroll 1
    for (int idx = F.tid; idx < 704; idx += 512) { float v_;
        if (idx < 640) { const int g_ = idx >> 7, r_ = (idx >> 6) & 1, n_ = idx & 63; const int cb_ = g_ == 0 ? C_WL : (g_ == 1 ? C_AL : (g_ == 2 ? C_WR + hc : (g_ == 3 ? C_WK + hc : C_WV + hc))); v_ = F.in[10][r_ * 1792 + (cb_ - 2048) + n_]; }
        else v_ = F.in[16][hc + (idx - 640)];
        ((float*)(L + RW_PAR))[idx] = v_; }
    if (F.tid == 0) *(unsigned*)(L + RW_PCNT) = 0u;
    if (F.tid < 64) ((float*)(L + RW_PCNT + 16))[F.tid] = F.in[18][hc + F.tid];
    for (int idx = F.tid; idx < 2176; idx += 512) ((unsigned*)(L + RW_ZERO))[idx] = 0u;
    if (F.tid < 192) { const int wh_ = F.tid >> 6, n_ = F.tid & 63; ((float*)(L + RW_UP + 18432))[F.tid] = wh_ == 0 ? F.in[11][d * 512 + hc + n_] : (wh_ == 1 ? F.in[13][d * 512 + hc + n_] : F.in[17][hc + n_]); }
    __syncthreads();
    if (F.wave < 4) {
        f32x4 X[4];
#pragma unroll
        for (int j = 0; j < 4; ++j) X[j] = (f32x4){0.f, 0.f, 0.f, 0.f};
        __syncthreads();
        for (int c = 0; c < NCH; ++c) {
            if (c > NCC) {
                const int fi = F.tid >> 3, fc8 = (F.tid & 7) * 8;
                const int s = (c - 1 - NCC) * RWC + fi, t = d ? SEQ - 1 - s : s;
                const unsigned char* Lyp = L + RW_Y + ((c - 1) & 1) * 8192;
                const f32x4 y0 = *(const f32x4*)(Lyp + (fi * 64 + fc8) * 4), y1 = *(const f32x4*)(Lyp + (fi * 64 + fc8 + 4) * 4);
                v4u o; o.x = pk2(y0.x, y0.y); o.y = pk2(y0.z, y0.w); o.z = pk2(y1.x, y1.y); o.w = pk2(y1.z, y1.w);
                *(v4u*)((bf16*)(F.ws + (d == 0 ? WS_YF : WS_YB)) + ((size_t)b * SEQ + t) * 512 + hc + fc8) = o;
            }
            if (d == 0 && c >= NCC) {
                const int fi = F.tid >> 3, fc8 = (F.tid & 7) * 8;
                const unsigned char* Lb = L + (c & 1) * RW_BUF; const int o4 = (fi * 64 + fc8) * 4;
                const f32x4 r0 = *(const f32x4*)(Lb + RW_R + o4), r1 = *(const f32x4*)(Lb + RW_R + o4 + 16), t0 = *(const f32x4*)(Lb + RW_KT + o4), t1 = *(const f32x4*)(Lb + RW_KT + o4 + 16);
                const f32x4 rk0 = *(const f32x4*)(L + RW_PCNT + 16 + fc8 * 4), rk1 = *(const f32x4*)(L + RW_PCNT + 16 + fc8 * 4 + 16);
                const f32x4 p0 = r0 * t0 * rk0, p1 = r1 * t1 * rk1;
                const float s = red8((p0.x + p0.y) + (p0.z + p0.w) + (p1.x + p1.y) + (p1.z + p1.w));
                if ((F.tid & 7) == 0) { const int t = (c - NCC) * RWC + fi; ((float*)(F.ws + WS_BONUS))[((size_t)b * SEQ + t) * 8 + h] = s; }
            }
            const unsigned char* Lin = L + (c & 1) * RW_BUF; unsigned char* Ly = L + RW_Y + (c & 1) * 8192;
            if (d == 0) { if (c >= NCC) rw_scan_chunk<true, true>(Lin, L, Ly, X, F.wave, F.lane); else rw_scan_chunk<true, false>(Lin, L, Ly, X, F.wave, F.lane); }
            else        { if (c >= NCC) rw_scan_chunk<false, true>(Lin, L, Ly, X, F.wave, F.lane); else rw_scan_chunk<false, false>(Lin, L, Ly, X, F.wave, F.lane); }
            __syncthreads();
        }
    } else {
        const bf16* P = (const bf16*)(F.ws + WS_P);
        const float* mu = F.in[10];
        const int p = F.wave - 4, mt = p & 1, mat = p >> 1, lane = F.lane, tid2 = F.tid - 256;
        const int row16 = lane >> 2, c16 = (lane & 3) * 16, irow = mt * 16 + row16;
        const int na = mat ? 2 : 3;
        const int colb[3] = {mat ? C_AL : C_WL, mat ? C_WK + hc : C_WR + hc, C_WV + hc};
        unsigned char* LA = L + RW_A + p * 2304;
        const unsigned char* LUP = L + RW_UP + mat * 9216;
        const float* biasp = (const float*)(L + RW_UP + 18432) + mat * 64 + (lane & 15); const float* kavp = (const float*)(L + RW_UP + 18432) + 128 + (lane & 15);
        const int bi = tid2 >> 3, bc8 = (tid2 & 7) * 8;
        float* BON = (float*)(F.ws + WS_BONUS);
        bf16* Yd = (bf16*)(F.ws + (d == 0 ? WS_YF : WS_YB));
        v4u raw[3][3][2];
#define RW_LOAD_RAW(c) do { const bool xph_ = (c) >= NCC; const int T_ = xph_ ? SEQ : CTXL; const int cc_ = xph_ ? (c) - NCC : (c); \
        const size_t base_ = xph_ ? (size_t)b * SEQ : (size_t)NX + (size_t)b * CTXL; const int s_ = cc_ * RWC + irow; const int t_ = d ? T_ - 1 - s_ : s_; \
        const bf16* pr_ = P + (base_ + t_) * INC + c16; \
        _Pragma("unroll") for (int a = 0; a < 3; ++a) if (a < na) { \
            raw[a][1][0] = *(const v4u*)(pr_ + colb[a]); raw[a][1][1] = *(const v4u*)(pr_ + colb[a] + 8); \
            if (t_ > 0) { raw[a][0][0] = *(const v4u*)(pr_ - INC + colb[a]); raw[a][0][1] = *(const v4u*)(pr_ - INC + colb[a] + 8); } else { raw[a][0][0] = (v4u){0u, 0u, 0u, 0u}; raw[a][0][1] = (v4u){0u, 0u, 0u, 0u}; } \
            if (t_ < T_ - 1) { raw[a][2][0] = *(const v4u*)(pr_ + INC + colb[a]); raw[a][2][1] = *(const v4u*)(pr_ + INC + colb[a] + 8); } else { raw[a][2][0] = (v4u){0u, 0u, 0u, 0u}; raw[a][2][1] = (v4u){0u, 0u, 0u, 0u}; } } } while (0)
#define RW_PREP(c) do { unsigned char* Lb_ = L + ((c) & 1) * RW_BUF; \
        _Pragma("unroll") for (int a = 0; a < 3; ++a) if (a < na) { \
            _Pragma("unroll") for (int hf = 0; hf < 2; ++hf) { \
                float pc_[8], pp_[8], pn_[8], m0_[8], m1_[8], sv_[8]; \
                unpack8(raw[a][1][hf], pc_); unpack8(raw[a][0][hf], pp_); unpack8(raw[a][2][hf], pn_); \
                const float* mp_ = (const float*)(L + RW_PAR) + (mat ? (a == 0 ? 1 : 3) : (a == 0 ? 0 : (a == 1 ? 2 : 4))) * 128 + c16 + hf * 8; ld8f(mp_, m0_); ld8f(mp_ + 64, m1_); \
                _Pragma("unroll") for (int j = 0; j < 8; ++j) sv_[j] = pc_[j] + m0_[j] * (pp_[j] - pc_[j]) + m1_[j] * (pn_[j] - pc_[j]); \
                if (a == 0) { \
                    if (mat == 0) { _Pragma("unroll") for (int j = 0; j < 8; ++j) { const float e_ = __expf(2.f * sv_[j]); sv_[j] = 1.f - 2.f * __builtin_amdgcn_rcpf(e_ + 1.f); } } \
                    *(v4u*)(LA + row16 * RW_TSTRIDE + (c16 + hf * 8) * 2) = pack8(sv_); \
                } else if (a == 1 && mat == 0) { \
                    { const int pb_ = irow * 128 + rw_perm(c16 + hf * 8) * 2; v2u lo_, hi_; lo_.x = pk2(sv_[0], sv_[1]); lo_.y = pk2(sv_[2], sv_[3]); hi_.x = pk2(sv_[4], sv_[5]); hi_.y = pk2(sv_[6], sv_[7]); \
                      *(v2u*)(Lb_ + RW_RI + pb_) = lo_; *(v2u*)(Lb_ + RW_RI + pb_ + 16) = hi_; } \
                    *(f32x4*)(Lb_ + RW_R + (irow * 64 + c16 + hf * 8) * 4) = (f32x4){sv_[0], sv_[1], sv_[2], sv_[3]}; *(f32x4*)(Lb_ + RW_R + (irow * 64 + c16 + hf * 8 + 4) * 4) = (f32x4){sv_[4], sv_[5], sv_[6], sv_[7]}; \
                } else if (a == 2) { \
                    *(f32x4*)(Lb_ + RW_V + (irow * 64 + c16 + hf * 8) * 4) = (f32x4){sv_[0], sv_[1], sv_[2], sv_[3]}; *(f32x4*)(Lb_ + RW_V + (irow * 64 + c16 + hf * 8 + 4) * 4) = (f32x4){sv_[4], sv_[5], sv_[6], sv_[7]}; \
                } else { \
                    *(f32x4*)(Lb_ + RW_KT + (irow * 64 + c16 + hf * 8) * 4) = (f32x4){sv_[0], sv_[1], sv_[2], sv_[3]}; *(f32x4*)(Lb_ + RW_KT + (irow * 64 + c16 + hf * 8 + 4) * 4) = (f32x4){sv_[4], sv_[5], sv_[6], sv_[7]};   \
                    float kk_[8]; ld8f((const float*)(L + RW_PAR) + 640 + c16 + hf * 8, kk_); \
                    _Pragma("unroll") for (int j = 0; j < 8; ++j) { krv[hf * 8 + j] = sv_[j] * kk_[j]; kss += krv[hf * 8 + j] * krv[hf * 8 + j]; } \
                } } } \
        if (mat == 1) { kss += dpp_mov<0xB1>(kss); kss += dpp_mov<0x4E>(kss); const float rn_ = __builtin_amdgcn_rsqf(kss + 1e-12f); \
            _Pragma("unroll") for (int q = 0; q < 4; ++q) { v2u w_; w_.x = pk2(krv[q * 4] * rn_, krv[q * 4 + 1] * rn_); w_.y = pk2(krv[q * 4 + 2] * rn_, krv[q * 4 + 3] * rn_); *(v2u*)(Lb_ + RW_KKI + irow * 128 + rw_perm(c16 + q * 4) * 2) = w_; } } \
        asm volatile("s_waitcnt lgkmcnt(0)" ::: "memory"); } while (0)
        float krv[16]; float kss;
#define RW_PSYNC(k) do { asm volatile("s_waitcnt lgkmcnt(0)" ::: "memory"); \
            if (lane == 0) __hip_atomic_fetch_add((unsigned*)(L + RW_PCNT), 1u, __ATOMIC_RELAXED, __HIP_MEMORY_SCOPE_WORKGROUP); \
            while (*(const volatile __attribute__((address_space(3))) unsigned*)(unsigned)(RW_PCNT) < 4u * (unsigned)(k)) __builtin_amdgcn_s_sleep(1); \
            asm volatile("" ::: "memory"); } while (0)
#define RW_PMFMA(Lb) do { const int vw_ = (p >> 1) * 4 + (p & 1) * 2; rw_mfma_part(L, (Lb), vw_, lane); rw_mfma_part(L, (Lb), vw_ + 1, lane); } while (0)
        RW_LOAD_RAW(0);
        kss = 0.f; RW_PREP(0);
        RW_PSYNC(1);
        RW_PMFMA(L);
        RW_LOAD_RAW(1);
        __syncthreads();
        for (int c = 0; c < NCH; ++c) {
            if (c + 1 < NCH) { kss = 0.f; RW_PREP(c + 1); RW_PSYNC(c + 2); RW_PMFMA(L + ((c + 1) & 1) * RW_BUF); }
            if (c + 2 < NCH) RW_LOAD_RAW(c + 2);
            __syncthreads();
        }
        {
            const int s = (NCH - 1 - NCC) * RWC + bi, t = d ? SEQ - 1 - s : s;
            const unsigned char* Ly = L + RW_Y + ((NCH - 1) & 1) * 8192;
            const f32x4 y0 = *(const f32x4*)(Ly + (bi * 64 + bc8) * 4), y1 = *(const f32x4*)(Ly + (bi * 64 + bc8 + 4) * 4);
            v4u o; o.x = pk2(y0.x, y0.y); o.y = pk2(y0.z, y0.w); o.z = pk2(y1.x, y1.y); o.w = pk2(y1.z, y1.w);
            *(v4u*)(Yd + ((size_t)b * SEQ + t) * 512 + hc + bc8) = o;
        }
#undef RW_LOAD_RAW
#undef RW_PREP
    }
    __syncthreads();
}

constexpr int RT_Q = 0, RT_K = 17408, RT_KT = 34816, RT_VT = 53248, RT_STG = 62464  , RT_P = 2 * RT_STG, RT_ST = RT_P + 9216, RT_END = RT_ST + 17408;
constexpr int RT_S136 = 272, RT_S72 = 144;
static_assert(RT_END <= LDS_BYTES, "retention LDS map");
__device__ __forceinline__ void ret_unit(Frame& F, int rid) {
    const int b = rid >> 4, h = (rid >> 2) & 3, dir = (rid >> 1) & 1, half = rid & 1;
    unsigned char* L = F.lds;
    const bf16* P = (const bf16*)(F.ws + WS_P);
    const float lg2 = -__expf(F.in[9][dir * 4 + h]) * 1.4426950408889634f;
    const float* rope_c = (const float*)(F.ws + WS_ROPE); const float* rope_s = rope_c + 2048;
    bf16* Od = (bf16*)(F.ws + (dir == 0 ? WS_OF : WS_OB));
    const int i_row = F.tid >> 3, sub = F.tid & 7, hs = sub >> 2, g = sub & 3, da = hs * 64 + g * 8, db = da + 32;
    const int w = F.wave, lane = F.lane, mt = w >> 1, ntb = (w & 1) * 2, et = w >> 1, dtb = (w & 1) * 4;
    for (int idx = F.tid; idx < 17408 / 4; idx += 512) ((unsigned*)(L + RT_ST))[idx] = 0u;
    f32x4 sacc[4];
#pragma unroll
    for (int q = 0; q < 4; ++q) sacc[q] = (f32x4){0.f, 0.f, 0.f, 0.f};
    const float gC = exp2f(lg2 * 64.f);
    const float kd = exp2f(lg2 * (float)(63 - i_row));
    constexpr int NCC = CTXL / 64, NCH = NCC + SEQ / 64;
    v4u rq[2], rk[2], rv;
#define RT_LOAD_RAW(c) do { const bool xph_ = (c) >= NCC; const int T_ = xph_ ? SEQ : CTXL; const int cc_ = xph_ ? (c) - NCC : (c); \
        const size_t base_ = xph_ ? (size_t)b * SEQ : (size_t)NX + (size_t)b * CTXL; const int s_ = cc_ * 64 + i_row; const int t_ = dir ? T_ - 1 - s_ : s_; \
        const bf16* pr_ = P + (base_ + t_) * INC; \
        rq[0] = *(const v4u*)(pr_ + C_RQ + h * 128 + da); rq[1] = *(const v4u*)(pr_ + C_RQ + h * 128 + db); \
        rk[0] = *(const v4u*)(pr_ + C_RK + h * 128 + da); rk[1] = *(const v4u*)(pr_ + C_RK + h * 128 + db); \
        rv = *(const v4u*)(pr_ + C_RV + h * 128 + half * 64 + sub * 8); } while (0)
#define RT_STAGE(c) do { unsigned char* Lb_ = L + ((c) & 1) * RT_STG; const bool xph_ = (c) >= NCC; const int T_ = xph_ ? SEQ : CTXL; const int cc_ = xph_ ? (c) - NCC : (c); \
        float qa[8], qb[8], ka[8], kb[8], vv[8]; \
        unpack8(rq[0], qa); unpack8(rq[1], qb); unpack8(rk[0], ka); unpack8(rk[1], kb); unpack8(rv, vv); \
        if (xph_) { \
            const int s = cc_ * 64 + i_row, t = dir ? T_ - 1 - s : s; const int pos = hs ? (t & 63) : (t >> 6); \
            const f32x4 c0 = *(const f32x4*)(rope_c + pos * 32 + g * 8), c1 = *(const f32x4*)(rope_c + pos * 32 + g * 8 + 4); \
            const f32x4 s0 = *(const f32x4*)(rope_s + pos * 32 + g * 8), s1 = *(const f32x4*)(rope_s + pos * 32 + g * 8 + 4); \
            _Pragma("unroll") for (int j = 0; j < 8; ++j) { const float cn = j < 4 ? c0[j & 3] : c1[j & 3], sn = j < 4 ? s0[j & 3] : s1[j & 3]; \
                const float a = qa[j], bq = qb[j]; qa[j] = a * cn - bq * sn; qb[j] = a * sn + bq * cn; \
                const float a2 = ka[j], b2 = kb[j]; ka[j] = a2 * cn - b2 * sn; kb[j] = a2 * sn + b2 * cn; } \
        } \
        _Pragma("unroll") for (int j = 0; j < 8; ++j) { ka[j] *= 0.08838834764831845f; kb[j] *= 0.08838834764831845f; } \
        *(v4u*)(Lb_ + RT_Q + i_row * RT_S136 + da * 2) = pack8(qa); *(v4u*)(Lb_ + RT_Q + i_row * RT_S136 + db * 2) = pack8(qb); \
        *(v4u*)(Lb_ + RT_K + i_row * RT_S136 + da * 2) = pack8(ka); *(v4u*)(Lb_ + RT_K + i_row * RT_S136 + db * 2) = pack8(kb); \
        _Pragma("unroll") for (int j = 0; j < 8; ++j) { \
            *(bf16*)(Lb_ + RT_KT + (da + j) * RT_S72 + i_row * 2) = (bf16)f2bf(ka[j] * kd); \
            *(bf16*)(Lb_ + RT_KT + (db + j) * RT_S72 + i_row * 2) = (bf16)f2bf(kb[j] * kd); \
            *(bf16*)(Lb_ + RT_VT + (sub * 8 + j) * RT_S72 + i_row * 2) = (bf16)f2bf(vv[j]); } } while (0)
    RT_LOAD_RAW(0);
    RT_STAGE(0);
    RT_LOAD_RAW(1);
    for (int c = 0; c < NCH; ++c) {
        const bool xph = c >= NCC; const int T = xph ? SEQ : CTXL; const int cc = xph ? c - NCC : c;
        const unsigned char* Lb = L + (c & 1) * RT_STG;
        __syncthreads();
        f32x4 oacc[2];
        {
            bf16x8 qf[4];
#pragma unroll
            for (int ks = 0; ks < 4; ++ks) qf[ks] = ldfrag(Lb + RT_Q, RT_S136, mt * 16, ks * 32, lane);
#pragma unroll
            for (int n2 = 0; n2 < 2; ++n2) {
                f32x4 a = {0.f, 0.f, 0.f, 0.f}, sc = {0.f, 0.f, 0.f, 0.f};
#pragma unroll
                for (int ks = 0; ks < 4; ++ks) { a = MFMA16(qf[ks], ldfrag(L + RT_ST, RT_S136, (ntb + n2) * 16, ks * 32, lane), a);
                                                 sc = MFMA16(qf[ks], ldfrag(Lb + RT_K, RT_S136, (ntb + n2) * 16, ks * 32, lane), sc); }
#pragma unroll
                for (int j = 0; j < 4; ++j) { const int i = mt * 16 + (lane >> 4) * 4 + j; const int jj = (ntb + n2) * 16 + (lane & 15); const int dist = i - jj;
                    a[j] *= exp2f(lg2 * (float)(i + 1));
                    const bool ok = dir ? (dist > 0) : (dist >= 0);
                    const float pv = ok ? sc[j] * exp2f(lg2 * (float)dist) : 0.f;
                    *(bf16*)(L + RT_P + i * RT_S72 + jj * 2) = (bf16)f2bf(pv); }
                oacc[n2] = a;
            }
        }
        if (c + 1 < NCH) { RT_STAGE(c + 1); if (c + 2 < NCH) RT_LOAD_RAW(c + 2); }
        __syncthreads();
        {
#pragma unroll
            for (int ks = 0; ks < 2; ++ks) { const bf16x8 pf = ldfrag(L + RT_P, RT_S72, mt * 16, ks * 32, lane);
#pragma unroll
                for (int n2 = 0; n2 < 2; ++n2) oacc[n2] = MFMA16(pf, ldfrag(Lb + RT_VT, RT_S72, (ntb + n2) * 16, ks * 32, lane), oacc[n2]); }
            if (xph) {
#pragma unroll
                for (int n2 = 0; n2 < 2; ++n2)
#pragma unroll
                    for (int j = 0; j < 4; ++j) { const int i = mt * 16 + (lane >> 4) * 4 + j; const int s = cc * 64 + i, t = dir ? T - 1 - s : s; const int e = (ntb + n2) * 16 + (lane & 15);
                        Od[((size_t)b * SEQ + t) * 512 + h * 128 + half * 64 + e] = (bf16)f2bf(oacc[n2][j]); }
            }
        }
        {
#pragma unroll
            for (int q = 0; q < 4; ++q) sacc[q] = sacc[q] * gC;
#pragma unroll
            for (int ks = 0; ks < 2; ++ks) { const bf16x8 vf = ldfrag(Lb + RT_VT, RT_S72, et * 16, ks * 32, lane);
#pragma unroll
                for (int q = 0; q < 4; ++q) sacc[q] = MFMA16(vf, ldfrag(Lb + RT_KT, RT_S72, (dtb + q) * 16, ks * 32, lane), sacc[q]); }
#pragma unroll
            for (int q = 0; q < 4; ++q)
#pragma unroll
                for (int j = 0; j < 4; ++j) { const int e = et * 16 + (lane >> 4) * 4 + j, dd = (dtb + q) * 16 + (lane & 15);
                    *(bf16*)(L + RT_ST + e * RT_S136 + dd * 2) = (bf16)f2bf(sacc[q][j]); }
        }
    }
    __syncthreads();
#undef RT_LOAD_RAW
#undef RT_STAGE
}

constexpr int MG_SG = 0, MG_G = 17408, MG_GSTRIDE = 1040;
__device__ __forceinline__ void merge_phase(Frame& F) {
    unsigned char* L = F.lds;
    const bf16* P = (const bf16*)(F.ws + WS_P);
    const bf16* YF = (const bf16*)(F.ws + WS_YF); const bf16* YB = (const bf16*)(F.ws + WS_YB);
    const bf16* OF = (const bf16*)(F.ws + WS_OF); const bf16* OB = (const bf16*)(F.ws + WS_OB);
    const float* BON = (const float*)(F.ws + WS_BONUS);
    const unsigned char* GUPT = F.ws + WS_GUPT;
    bf16* MIXA = (bf16*)(F.ws + WS_MIXA);
    const float* mu = F.in[10];
    const int i_row = F.tid >> 3, sub = F.tid & 7, w = F.wave, lane = F.lane;
    float cm0[8], cm1[8], clw[8], clb[8];
    ld8f(mu + (C_WV - 2048) + lane * 8, cm0); ld8f(mu + 1792 + (C_WV - 2048) + lane * 8, cm1); ld8f(F.in[19] + lane * 8, clw); ld8f(F.in[20] + lane * 8, clb);
    for (int tl = F.bid; tl < NX / 64; tl += F.G) {
        const int m = tl * 64 + i_row, t = m & (SEQ - 1);
        const bf16* pr = P + (size_t)m * INC;
        bf16x8 gfr[4][4];
#pragma unroll
        for (int nt = 0; nt < 4; ++nt)
#pragma unroll
            for (int ks = 0; ks < 4; ++ks) gfr[nt][ks] = ldfrag(GUPT, 256, w * 64 + nt * 16, ks * 32, lane);
        {
#pragma unroll
            for (int q = 0; q < 2; ++q) { const int col = sub * 16 + q * 8;
                float p[8], pp[8], pn[8], o[8];
                unpack8(*(const v4u*)(pr + C_GL + col), p);
                if (t > 0) unpack8(*(const v4u*)(pr - INC + C_GL + col), pp); else { for (int j = 0; j < 8; ++j) pp[j] = 0.f; }
                if (t < SEQ - 1) unpack8(*(const v4u*)(pr + INC + C_GL + col), pn); else { for (int j = 0; j < 8; ++j) pn[j] = 0.f; }
                float m0[8], m1[8]; ld8f(mu + (C_GL - 2048) + col, m0); ld8f(mu + 1792 + (C_GL - 2048) + col, m1);
#pragma unroll
                for (int j = 0; j < 8; ++j) o[j] = sigmoidf_(p[j] + m0[j] * (pp[j] - p[j]) + m1[j] * (pn[j] - p[j]));
                *(v4u*)(L + MG_SG + i_row * RT_S136 + col * 2) = pack8(o); }
        }
        __syncthreads();
        {
#pragma unroll
            for (int mt = 0; mt < 4; ++mt) {
                f32x4 acc[4];
#pragma unroll
                for (int nt = 0; nt < 4; ++nt) acc[nt] = (f32x4){0.f, 0.f, 0.f, 0.f};
#pragma unroll
                for (int ks = 0; ks < 4; ++ks) { const bf16x8 af = ldfrag(L + MG_SG, RT_S136, mt * 16, ks * 32, lane);
#pragma unroll
                    for (int nt = 0; nt < 4; ++nt) acc[nt] = MFMA16(gfr[nt][ks], af, acc[nt]); }
#pragma unroll
                for (int nt = 0; nt < 4; ++nt) { v2u o_; o_.x = pk2(acc[nt][0], acc[nt][1]); o_.y = pk2(acc[nt][2], acc[nt][3]);
                    *(v2u*)(L + MG_G + (mt * 16 + (lane & 15)) * MG_GSTRIDE + (w * 64 + nt * 16 + (lane >> 4) * 4) * 2) = o_; }
            }
        }
        __syncthreads();
#pragma unroll 2
        for (int tt = 0; tt < 8; ++tt) {
            const int ti = tt * 8 + w, mm = tl * 64 + ti, t2 = mm & (SEQ - 1);
            const bf16* pr2 = P + (size_t)mm * INC;
            const int col = lane * 8;
            {
                float a[8], bb[8], y[8], p8[8], pp[8], pn[8], gg[8], o[8];
                unpack8(__builtin_nontemporal_load((const v4u*)(YF + (size_t)mm * 512 + col)), a); unpack8(__builtin_nontemporal_load((const v4u*)(YB + (size_t)mm * 512 + col)), bb);
                unpack8(*(const v4u*)(pr2 + C_WV + col), p8);
                if (t2 > 0) unpack8(*(const v4u*)(pr2 - INC + C_WV + col), pp); else { for (int j = 0; j < 8; ++j) pp[j] = 0.f; }
                if (t2 < SEQ - 1) unpack8(*(const v4u*)(pr2 + INC + C_WV + col), pn); else { for (int j = 0; j < 8; ++j) pn[j] = 0.f; }
                const float bonus = BON[(size_t)mm * 8 + (lane >> 3)];
                unpack8(*(const v4u*)(L + MG_G + ti * MG_GSTRIDE + col * 2), gg);
                float s = 0.f, s2 = 0.f;
#pragma unroll
                for (int j = 0; j < 8; ++j) { y[j] = a[j] + bb[j]; s += y[j]; s2 += y[j] * y[j]; }
                s = red8(s); s2 = red8(s2);
                const float mean = s * (1.f / 64.f);
                const float rstd = __builtin_amdgcn_rsqf(fmaxf(s2 * (1.f / 64.f) - mean * mean, 0.f) + 64e-5f);
#pragma unroll
                for (int j = 0; j < 8; ++j) {
                    const float vsft = p8[j] + cm0[j] * (pp[j] - p8[j]) + cm1[j] * (pn[j] - p8[j]);
                    o[j] = ((y[j] - mean) * rstd * clw[j] + clb[j] + bonus * vsft) * gg[j]; }
                *(v4u*)(MIXA + (size_t)mm * DM + 512 + col) = pack8(o);
            }
            {
                float a[8], bb[8], gt[8], r[8]; float ss = 0.f;
                unpack8(__builtin_nontemporal_load((const v4u*)(OF + (size_t)mm * 512 + col)), a); unpack8(__builtin_nontemporal_load((const v4u*)(OB + (size_t)mm * 512 + col)), bb);
                unpack8(*(const v4u*)(pr2 + C_RG + col), gt);
#pragma unroll
                for (int j = 0; j < 8; ++j) { a[j] += bb[j]; ss += a[j] * a[j]; }
                ss = red16(ss);
                const float rms = __builtin_amdgcn_rsqf(ss * (1.f / 128.f) + 1e-6f);
#pragma unroll
                for (int j = 0; j < 8; ++j) r[j] = a[j] * rms * (gt[j] * sigmoidf_(gt[j]));
                *(v4u*)(MIXA + (size_t)mm * DM + col) = pack8(r);
            }
        }
    }
    __syncthreads();
}

#define LAS __attribute__((address_space(3)))
#define XB_TMO      128
#define XB_XCNT(j)  (256  + 64 * (j))
#define XB_XSUB(j)  (1280 + 64 * (j))
#define XB_XGEN(j)  (2304 + 64 * (j))
#define XB_TOP      3328
#define XB_TOPGEN   3392
#define XCD_BAR_WORDS 3456
#define XB_SPIN_CAP (1u << 18)

__device__ __forceinline__ unsigned xb_ld(unsigned* p)              { return __hip_atomic_load(p, __ATOMIC_RELAXED, __HIP_MEMORY_SCOPE_AGENT); }
__device__ __forceinline__ unsigned xb_add(unsigned* p, unsigned v) { return __hip_atomic_fetch_add(p, v, __ATOMIC_RELAXED, __HIP_MEMORY_SCOPE_AGENT); }
__device__ __forceinline__ unsigned xb_xcc_id() { return (unsigned)__builtin_amdgcn_s_getreg((3 << 11) | 20) & 0xFu; }
#define XB_SPIN(cond, bar) do { unsigned _sp = 0; while (cond) { __builtin_amdgcn_s_sleep(1); \
    if ((++_sp & 255u) == 0u) { if (xb_ld(&(bar)[XB_TMO])) break; if (_sp > XB_SPIN_CAP) { atomicAdd(&(bar)[XB_TMO], 1u); break; } } } } while (0)

struct XcdBarrier {
    unsigned* bar; unsigned x;
    volatile LAS unsigned* st;
};

__device__ __forceinline__ XcdBarrier xcd_barrier_post(unsigned* bar, volatile LAS unsigned* st) {
    XcdBarrier b; b.bar = bar; b.x = xb_xcc_id(); b.st = st;
    if (threadIdx.x == 0) (void)xb_add(&bar[XB_XCNT(b.x)], 1u);
    return b;
}
__device__ __forceinline__ void xcd_barrier_complete(unsigned* bar, unsigned x, unsigned& nloc, unsigned& nx) {
    const unsigned G = gridDim.x * gridDim.y * gridDim.z;
    unsigned sum, cnt, mine, sp = 0u;
    for (;;) {
        sum = 0u; cnt = 0u; mine = 0u;
#pragma unroll
        for (unsigned j = 0; j < 16; ++j) { const unsigned c = xb_ld(&bar[XB_XCNT(j)]); sum += c; cnt += (c > 0u) ? 1u : 0u; mine = (j == x) ? c : mine; }
        if (sum == G) break;
        __builtin_amdgcn_s_sleep(1);
        if ((++sp & 255u) == 0u) { if (xb_ld(&bar[XB_TMO])) break; if (sp > XB_SPIN_CAP) { atomicAdd(&bar[XB_TMO], 1u); break; } }
    }
    nloc = mine > 0u ? mine : 1u; nx = cnt > 0u ? cnt : 1u;
}

__device__ __forceinline__ void xcd_barrier(const XcdBarrier& b) {
    asm volatile("s_waitcnt vmcnt(0)" ::: "memory");
    __syncthreads();
    if (threadIdx.x == 0) {
        unsigned* bar = b.bar;
        __builtin_amdgcn_s_waitcnt(0);
        unsigned nloc = b.st[0], nx = b.st[1];
        if (nloc == 0u) { xcd_barrier_complete(bar, b.x, nloc, nx); b.st[0] = nloc; b.st[1] = nx; }
        const unsigned old = xb_add(&bar[XB_XSUB(b.x)], 1u);
        const unsigned gen = old / nloc;
        if (old + 1u == (gen + 1u) * nloc) {
            __builtin_amdgcn_fence(__ATOMIC_RELEASE, "agent");
            asm volatile("s_waitcnt vmcnt(0)" ::: "memory");
            const unsigned og = xb_add(&bar[XB_TOP], 1u);
            const unsigned tg = og / nx;
            if (og + 1u == (tg + 1u) * nx) xb_add(&bar[XB_TOPGEN], 1u);
            else XB_SPIN(xb_ld(&bar[XB_TOPGEN]) == tg, bar);
            __builtin_amdgcn_fence(__ATOMIC_ACQUIRE, "agent");
            xb_add(&bar[XB_XGEN(b.x)], 1u);
            asm volatile("s_waitcnt vmcnt(0)" ::: "memory");
        } else {
            XB_SPIN(xb_ld(&bar[XB_XGEN(b.x)]) == gen, bar);
            __builtin_amdgcn_fence(__ATOMIC_ACQUIRE, "agent");
            asm volatile("s_waitcnt vmcnt(0)" ::: "memory");
        }
    }
    __syncthreads();
}

struct Args { const float* in[27]; float* out; unsigned char* ws; int never; int pad; };
__global__ void __launch_bounds__(NWAVES * 64, 2) fwd_megakernel(Args args) {
    extern __shared__ __attribute__((aligned(16))) unsigned char lds[];
    cg::grid_group grid = cg::this_grid();
    Frame F;
    F.lds = lds; F.tid = threadIdx.x; F.lane = F.tid & 63; F.wave = __builtin_amdgcn_readfirstlane(F.tid >> 6); F.G = gridDim.x; F.bid = blockIdx.x;
#pragma unroll
    for (int i = 0; i < 27; ++i) F.in[i] = args.in[i];
    F.out = args.out; F.ws = args.ws;
    PG8_LAS unsigned char* glds = (PG8_LAS unsigned char*)lds;
    for (int u = F.tid; u < 16; u += NWAVES * 64) ((unsigned*)(lds + LDS_BYTES - 64))[u] = 0u;
    __syncthreads();
    XcdBarrier xbar = xcd_barrier_post((unsigned*)(F.ws + WS_CTL), (volatile LAS unsigned*)(lds + LDS_BYTES - 64));
    if (args.never) grid.sync();
#define GRID_SYNC() do { xcd_barrier(xbar); asm volatile("" : "+v"(F.tid)); F.lane = F.tid & 63; } while (0)

    p0_phase(F);
    GRID_SYNC();
    norm_phase<0>(F);
    GRID_SYNC();
    {
        pg8::Gemm g{(const pg8::bf16_t*)(F.ws + WS_XN), (const pg8::bf16_t*)(F.ws + WS_WIN), NTOK, INC, DM}; pg8::StaticOrder S; S.init(NTOK, INC, F.G, F.bid);
        pg8::EpiBf16<0> E{(pg8::bf16_t*)(F.ws + WS_P), INC, nullptr};
        pg8::gemm_phase<pg8::EpiBf16<0>, pg8::StaticOrder, true, true>(glds, g, S, E);
        const int nun = (NTOK / 256) * (INC / 256);
        const int fb_ = (nun % F.G) ? (nun % F.G) : 0;
        cmat_phase(F, fb_);
        wconv_tail(F, fb_);
    }
    GRID_SYNC();
    for (int sid = F.bid; sid < 256; sid += F.G) rwkv_scan_unit(F, sid);
    asm volatile("" : "+v"(F.tid)); F.lane = F.tid & 63;
    for (int rid = F.bid; rid < 256; rid += F.G) ret_unit(F, rid);
    GRID_SYNC();
    merge_phase(F);
    GRID_SYNC();
    {
        pg8::Gemm g{(const pg8::bf16_t*)(F.ws + WS_MIXA), (const pg8::bf16_t*)(F.ws + WS_WOUT), NX, DM, DM}; pg8::StaticOrder S; S.init(NX, DM, F.G, F.bid);
        pg8::EpiResidNorm E{F.in[0], F.out, DM, (const float*)(F.ws + WS_ADA) + 2 * DM, ADA_LD, SEQ, F.in[7], (const float*)(F.ws + WS_ADA) + 4 * DM, (pg8::bf16_t*)(F.ws + WS_XN2), (float*)(F.ws + WS_SS)};
        pg8::gemm_phase<pg8::EpiResidNorm, pg8::StaticOrder, true, true>(glds, g, S, E);
    }
    GRID_SYNC();
    {
        pg8::Gemm g{(const pg8::bf16_t*)(F.ws + WS_XN2), (const pg8::bf16_t*)(F.ws + WS_W1), NX, DFF, DM}; pg8::StaticOrder S; S.init(NX, DFF, F.G, F.bid);
        pg8::EpiBf16Row E{(pg8::bf16_t*)(F.ws + WS_P), DFF, (const float*)(F.ws + WS_CMAT), SEQ, (const float*)(F.ws + WS_SS), 1.0f / DM, 1e-6f};
        pg8::gemm_phase<pg8::EpiBf16Row, pg8::StaticOrder, true, true>(glds, g, S, E);
    }
    GRID_SYNC();
    {
        pg8::Gemm g{(const pg8::bf16_t*)(F.ws + WS_P), (const pg8::bf16_t*)(F.ws + WS_W2), NX, DM, DFF}; pg8::StaticOrder S; S.init(NX, DM, F.G, F.bid);
        pg8::EpiResid E{F.out, F.out, DM, F.in[25], (const float*)(F.ws + WS_ADA) + 5 * DM, ADA_LD, SEQ};
        pg8::gemm_phase<pg8::EpiResid, pg8::StaticOrder, true, true>(glds, g, S, E);
    }
    GRID_SYNC();
    norm_phase<2>(F);
}

extern "C" void kernel_launch(void* const* d_in, const int* in_sizes, int n_in, void* d_out, int out_size, void* d_ws, size_t ws_size, hipStream_t stream) {
    static int grid = 0;
    if (grid == 0) {
        if (n_in != 27 || in_sizes[0] != NX * DM || out_size != NX * DM || ws_size < WS_END) { fprintf(stderr, "kernel_launch: unexpected shapes (n_in %d, in0 %d, out %d, ws %zu)\n", n_in, n_in > 0 ? in_sizes[0] : -1, out_size, ws_size); grid = -1; return; }
        int dev = 0, cus = 0, per_cu = 0;
        if (hipGetDevice(&dev) != hipSuccess || hipDeviceGetAttribute(&cus, hipDeviceAttributeMultiprocessorCount, dev) != hipSuccess) { grid = -1; return; }
        if (hipFuncSetAttribute((const void*)fwd_megakernel, hipFuncAttributeMaxDynamicSharedMemorySize, LDS_BYTES) != hipSuccess) { fprintf(stderr, "kernel_launch: hipFuncSetAttribute failed\n"); grid = -1; return; }
        if (hipOccupancyMaxActiveBlocksPerMultiprocessor(&per_cu, (const void*)fwd_megakernel, NWAVES * 64, LDS_BYTES) != hipSuccess || per_cu < 1) { fprintf(stderr, "kernel_launch: occupancy query says %d\n", per_cu); per_cu = 1; }
        (void)hipGetLastError();
        grid = cus;
    }
    if (grid < 0) return;
    if (hipMemsetAsync((char*)d_ws + WS_CTL, 0, 512 * 1024, stream) != hipSuccess) { fprintf(stderr, "kernel_launch: memset failed\n"); return; }
    Args a{};
    for (int i = 0; i < 27; ++i) a.in[i] = (const float*)d_in[i];
    a.out = (float*)d_out; a.ws = (unsigned char*)d_ws; a.never = 0; a.pad = 0;
    void* kargs[] = {&a};
    hipError_t e = hipLaunchCooperativeKernel((const void*)fwd_megakernel, dim3(grid), dim3(NWAVES * 64), kargs, LDS_BYTES, stream);
    if (e != hipSuccess) fprintf(stderr, "kernel_launch: cooperative launch failed: %s (grid %d)\n", hipGetErrorString(e), grid);
}
```

```cpp
#include <hip/hip_runtime.h>
#include <hip/hip_cooperative_groups.h>
#include <cstdio>
#include <cstdint>
namespace cg = cooperative_groups;
namespace pg8 {
#define PG8_LAS __attribute__((address_space(3)))
typedef unsigned short bf16_t;
typedef short bf16x8 __attribute__((ext_vector_type(8)));
typedef float f32x4 __attribute__((ext_vector_type(4)));
typedef unsigned u32x4 __attribute__((ext_vector_type(4)));
constexpr int BM = 256, BK = 64, HALF = 128, HTB = HALF * BK * 2  , STAGE_BYTES = 8 * HTB, NXCD = 8, WGM = 8;

__host__ __device__ __forceinline__ int lds_byte(int r, int c) { const int st = (r >> 4) * 2 + (c >> 5), rr = r & 15, cc = c & 31, ob = rr * 64 + cc * 2; return st * 1024 + (ob ^ (((ob >> 9) & 1) << 5)); }
__host__ __device__ __forceinline__ void stage_rc(int b, int& R, int& C) { const int st = b / 1024, sb = b % 1024, swz = sb ^ (((sb >> 9) & 1) << 5); R = (st >> 1) * 16 + swz / 64; C = (st & 1) * 32 + (swz % 64) / 2; }
__host__ __device__ __forceinline__ int perm32(int rho) { const int n = rho >> 4, i = rho & 15; return 8 * (i >> 2) + 4 * n + (i & 3); }

struct Unit { int pm, pn; };
struct Gemm { const bf16_t* A; const bf16_t* Bt; int M, N, K; };

struct StaticOrder {
    int nM, nN, nwg, G, c;
    __host__ __device__ void init(int M, int N, int G_, int c_) { nM = M / BM; nN = N / BM; nwg = nM * nN; G = G_; c = c_; }
    __host__ __device__ bool next(int i, Unit& u) const {
        const long L = (long)i * G + c; if (L >= nwg) return false;
        int wgid = (int)L; { const int q = nwg / NXCD, r = nwg % NXCD, xcd = wgid % NXCD, off = wgid / NXCD; wgid = (xcd < r ? xcd * (q + 1) : r * (q + 1) + (xcd - r) * q) + off; }
        const int nig = WGM * nN, gid = wgid / nig, fm = gid * WGM, gsz = (nM - fm) < WGM ? (nM - fm) : WGM;
        u.pm = fm + ((wgid % nig) % gsz); u.pn = (wgid % nig) / gsz; return true;
    }
    __device__ __forceinline__ void a_ready(const Unit&) const {}
    __device__ __forceinline__ void done(const Unit&) const {}
};

__device__ __forceinline__ unsigned cvt_pk_bf16(float lo, float hi) { unsigned r; asm volatile("v_cvt_pk_bf16_f32 %0, %1, %2" : "=v"(r) : "v"(lo), "v"(hi)); return r; }

template <int ACT> struct EpiBf16 {
    static constexpr bool PERM = true, AFTER_DRAIN = false;
    bf16_t* O; int ldc; const float* bias;
    __device__ __forceinline__ void operator()(const f32x4 (&acc)[2][2][4][2], const Unit& u, int wr, int wc, int fr, int fq) const {
        const int row0 = u.pm * BM + wr * 64 + fr; const int col0 = u.pn * BM + wc * 32 + 8 * fq;
        f32x4 bv[2][2];
#pragma unroll
        for (int bj = 0; bj < 2; ++bj)
#pragma unroll
            for (int n = 0; n < 2; ++n) bv[bj][n] = bias ? *(const f32x4*)(bias + col0 + bj * HALF + 4 * n) : (f32x4){0.f, 0.f, 0.f, 0.f};
#pragma unroll
        for (int ai = 0; ai < 2; ++ai)
#pragma unroll
            for (int m = 0; m < 4; ++m) { bf16_t* rowp = O + (size_t)(row0 + ai * HALF + m * 16) * ldc + col0;
#pragma unroll
                for (int bj = 0; bj < 2; ++bj) { f32x4 v0 = acc[ai][bj][m][0] + bv[bj][0], v1 = acc[ai][bj][m][1] + bv[bj][1];
                    if (ACT == 2) {
#pragma unroll
                        for (int q = 0; q < 4; ++q) { float a = fmaxf(v0[q], 0.f), b = fmaxf(v1[q], 0.f); v0[q] = a * a; v1[q] = b * b; }
                    }
                    u32x4 w; w.x = cvt_pk_bf16(v0[0], v0[1]); w.y = cvt_pk_bf16(v0[2], v0[3]); w.z = cvt_pk_bf16(v1[0], v1[1]); w.w = cvt_pk_bf16(v1[2], v1[3]);
                    *(u32x4*)(rowp + bj * HALF) = w; } }
    }
};
typedef unsigned u32x2v __attribute__((ext_vector_type(2)));

struct EpiResidNorm {
    static constexpr bool PERM = false, AFTER_DRAIN = false;
    const float* base; float* out; int ldc; const float* gate; int gate_ld; int rows_per_gate; const float* ng; const float* sc2; bf16_t* a2; float* ss;
    __device__ __forceinline__ void operator()(const f32x4 (&acc)[2][2][4][2], const Unit& u, int wr, int wc, int fr, int fq) const {
        const int col0 = u.pn * BM + wc * 32 + 4 * fq;
        const size_t bofs = (size_t)((u.pm * BM) / rows_per_gate) * gate_ld;
        f32x4 gv[2][2], nv[2][2];
#pragma unroll
        for (int bj = 0; bj < 2; ++bj)
#pragma unroll
            for (int n = 0; n < 2; ++n) { const int c = col0 + bj * HALF + n * 16; gv[bj][n] = *(const f32x4*)(gate + bofs + c);
                nv[bj][n] = *(const f32x4*)(ng + c) * (*(const f32x4*)(sc2 + bofs + c) + 1.0f); }
#pragma unroll
        for (int ai = 0; ai < 2; ++ai)
#pragma unroll
            for (int m = 0; m < 4; ++m) { const int row = u.pm * BM + ai * HALF + wr * 64 + m * 16 + fr; const size_t off = (size_t)row * ldc + col0; float sq = 0.f;
#pragma unroll
                for (int bj = 0; bj < 2; ++bj)
#pragma unroll
                    for (int n = 0; n < 2; ++n) { const f32x4 h = __builtin_nontemporal_load((const f32x4*)(base + off + bj * HALF + n * 16)) + gv[bj][n] * acc[ai][bj][m][n];
                        *(f32x4*)(out + off + bj * HALF + n * 16) = h;
                        sq += (h[0] * h[0] + h[1] * h[1]) + (h[2] * h[2] + h[3] * h[3]);
                        const f32x4 a = h * nv[bj][n]; u32x2v w; w.x = cvt_pk_bf16(a[0], a[1]); w.y = cvt_pk_bf16(a[2], a[3]);
                        *(u32x2v*)(a2 + off + bj * HALF + n * 16) = w; }
                sq += __shfl_xor(sq, 16); sq += __shfl_xor(sq, 32);
                if (fq == 0) atomicAdd(ss + row, sq); }
    }
};
struct EpiBf16Row {
    static constexpr bool PERM = true, AFTER_DRAIN = false;
    bf16_t* O; int ldc; const float* cvec; int rows_per_b; const float* ss; float inv_k, eps;
    __device__ __forceinline__ void operator()(const f32x4 (&acc)[2][2][4][2], const Unit& u, int wr, int wc, int fr, int fq) const {
        const int row0 = u.pm * BM + wr * 64 + fr; const int col0 = u.pn * BM + wc * 32 + 8 * fq;
        const float* cp = cvec + (size_t)((u.pm * BM) / rows_per_b) * ldc;
        f32x4 bv[2][2];
#pragma unroll
        for (int bj = 0; bj < 2; ++bj)
#pragma unroll
            for (int n = 0; n < 2; ++n) bv[bj][n] = *(const f32x4*)(cp + col0 + bj * HALF + 4 * n);
#pragma unroll
        for (int ai = 0; ai < 2; ++ai)
#pragma unroll
            for (int m = 0; m < 4; ++m) { const int row = row0 + ai * HALF + m * 16; bf16_t* rowp = O + (size_t)row * ldc + col0;
                const float rs = __builtin_amdgcn_rsqf(ss[row] * inv_k + eps);
#pragma unroll
                for (int bj = 0; bj < 2; ++bj) { f32x4 v0 = acc[ai][bj][m][0] * rs + bv[bj][0], v1 = acc[ai][bj][m][1] * rs + bv[bj][1];
#pragma unroll
                    for (int q = 0; q < 4; ++q) { float a = fmaxf(v0[q], 0.f), b = fmaxf(v1[q], 0.f); v0[q] = a * a; v1[q] = b * b; }
                    u32x4 w; w.x = cvt_pk_bf16(v0[0], v0[1]); w.y = cvt_pk_bf16(v0[2], v0[3]); w.z = cvt_pk_bf16(v1[0], v1[1]); w.w = cvt_pk_bf16(v1[2], v1[3]);
                    *(u32x4*)(rowp + bj * HALF) = w; } }
    }
};

struct EpiResid {
    static constexpr bool PERM = false, AFTER_DRAIN = false;
    const float* base; float* out; int ldc; const float* bias; const float* gate; int gate_ld; int rows_per_gate;
    __device__ __forceinline__ void operator()(const f32x4 (&acc)[2][2][4][2], const Unit& u, int wr, int wc, int fr, int fq) const {
        const int col0 = u.pn * BM + wc * 32 + 4 * fq;
        const float* gp = gate + (size_t)((u.pm * BM) / rows_per_gate) * gate_ld;
        f32x4 gv[2][2], bv[2][2];
#pragma unroll
        for (int bj = 0; bj < 2; ++bj)
#pragma unroll
            for (int n = 0; n < 2; ++n) { gv[bj][n] = *(const f32x4*)(gp + col0 + bj * HALF + n * 16);
                bv[bj][n] = bias ? *(const f32x4*)(bias + col0 + bj * HALF + n * 16) : (f32x4){0.f, 0.f, 0.f, 0.f}; }
#pragma unroll
        for (int ai = 0; ai < 2; ++ai)
#pragma unroll
            for (int m = 0; m < 4; ++m) { const size_t off = (size_t)(u.pm * BM + ai * HALF + wr * 64 + m * 16 + fr) * ldc + col0;
#pragma unroll
                for (int bj = 0; bj < 2; ++bj)
#pragma unroll
                    for (int n = 0; n < 2; ++n) { const f32x4 bs = *(const f32x4*)(base + off + bj * HALF + n * 16);
                        *(f32x4*)(out + off + bj * HALF + n * 16) = bs + gv[bj][n] * (acc[ai][bj][m][n] + bv[bj][n]); } }
    }
};

template <class Epi, class Sched, bool ALIGN_EPI = false, bool SP2 = false>
__device__ __forceinline__ void gemm_phase(PG8_LAS unsigned char* lds, const Gemm g, const Sched& S, const Epi& E) {
    int tid_ = threadIdx.x; asm volatile("" : "+v"(tid_));
    const int tid = tid_, wid = __builtin_amdgcn_readfirstlane(tid >> 6), lane = tid & 63, wr = wid >> 2, wc = wid & 3, fr = lane & 15, fq = lane >> 4;
    const int K = g.K, nt = K / BK;
    unsigned voffA[2], voffB[2];
#pragma unroll
    for (int i = 0; i < 2; ++i) { int R, C; stage_rc(tid * 16 + i * 8192, R, C); const int Rb = Epi::PERM ? ((R & ~31) + perm32(R & 31)) : R;
        voffA[i] = (unsigned)(R * K + C) * 2u; voffB[i] = (unsigned)(Rb * K + C) * 2u; }
    const size_t kstep = (size_t)(BK * 2);
    const size_t hstep = (size_t)HALF * K * 2;
    const size_t tstep = 2 * hstep;
    const unsigned ldsw = (unsigned)wid * 1024u;
    const int aoff = lds_byte(wr * 64 + fr, fq * 8), boff = lds_byte(wc * 32 + fr, fq * 8);
#define PG8_SA(b, h) (((b) * 2 + (h)) * HTB)
#define PG8_SB(b, h) ((4 + (b) * 2 + (h)) * HTB)
#define PG8_STAGE(bufoff, gbase, voff) do { _Pragma("unroll") for (int _i = 0; _i < 2; ++_i) \
        __builtin_amdgcn_global_load_lds((const unsigned*)((const char*)(gbase) + (voff)[_i]), (PG8_LAS unsigned*)(lds + (bufoff) + ldsw + _i * 8192), 16, 0, 0); } while (0)
#define PG8_LDA(dst, b, h) do { _Pragma("unroll") for (int m = 0; m < 4; ++m) _Pragma("unroll") for (int k = 0; k < 2; ++k) dst[m][k] = *(const PG8_LAS bf16x8*)(lds + PG8_SA(b, h) + aoff + m * 2048 + k * 1024); } while (0)
#define PG8_LDB(dst, b, h) do { _Pragma("unroll") for (int n = 0; n < 2; ++n) _Pragma("unroll") for (int k = 0; k < 2; ++k) dst[n][k] = *(const PG8_LAS bf16x8*)(lds + PG8_SB(b, h) + boff + n * 2048 + k * 1024); } while (0)
#define PG8_MMA(ai, bj, At, Bt) do { __builtin_amdgcn_s_setprio(1); _Pragma("unroll") for (int m = 0; m < 4; ++m) _Pragma("unroll") for (int n = 0; n < 2; ++n) _Pragma("unroll") for (int k = 0; k < 2; ++k) \
        acc[ai][bj][m][n] = __builtin_amdgcn_mfma_f32_16x16x32_bf16(Bt[n][k], At[m][k], acc[ai][bj][m][n], 0, 0, 0); __builtin_amdgcn_s_setprio(0); } while (0)
#define PG8_WAIT_V(n) asm volatile("s_waitcnt vmcnt(" #n ")" ::: "memory")
#define PG8_WAIT_L(n) asm volatile("s_waitcnt lgkmcnt(" #n ")" ::: "memory")
#define PG8_BAR __builtin_amdgcn_s_barrier()
#define PG8_SCHED __builtin_amdgcn_sched_barrier(0)
    Unit cur, nxt; int ui = 0;
    if (!S.next(0, cur)) return;
    f32x4 acc[2][2][4][2];
#pragma unroll
    for (int a = 0; a < 2; ++a)
#pragma unroll
        for (int b = 0; b < 2; ++b)
#pragma unroll
            for (int m = 0; m < 4; ++m)
#pragma unroll
                for (int n = 0; n < 2; ++n) acc[a][b][m][n] = (f32x4){0.f, 0.f, 0.f, 0.f};
    bf16x8 At[4][2], B0[2][2], B1[2][2];
    const char* cA = (const char*)g.A + (size_t)cur.pm * tstep; const char* cB = (const char*)g.Bt + (size_t)cur.pn * tstep;
    S.a_ready(cur);
    if constexpr (SP2) {
        PG8_STAGE(PG8_SB(0, 0), cB, voffB); PG8_STAGE(PG8_SB(0, 1), cB + hstep, voffB); PG8_STAGE(PG8_SA(0, 0), cA, voffA); PG8_STAGE(PG8_SA(0, 1), cA + hstep, voffA);
        if (wr == 1) PG8_BAR;
        PG8_WAIT_V(2); PG8_BAR;
        PG8_STAGE(PG8_SB(1, 0), cB + kstep, voffB); PG8_STAGE(PG8_SA(1, 0), cA + kstep, voffA); PG8_STAGE(PG8_SB(1, 1), cB + hstep + kstep, voffB);
        PG8_WAIT_V(6); PG8_BAR;
    } else {
        PG8_STAGE(PG8_SB(0, 0), cB, voffB); PG8_STAGE(PG8_SA(0, 0), cA, voffA); PG8_STAGE(PG8_SB(0, 1), cB + hstep, voffB); PG8_STAGE(PG8_SA(0, 1), cA + hstep, voffA);
        if (wr == 1) PG8_BAR;
        PG8_WAIT_V(4); PG8_BAR;
        PG8_STAGE(PG8_SB(1, 0), cB + kstep, voffB); PG8_STAGE(PG8_SA(1, 0), cA + kstep, voffA); PG8_STAGE(PG8_SB(1, 1), cB + hstep + kstep, voffB);
        PG8_WAIT_V(6); PG8_BAR;
    }
    for (;;) {
        const bool has_next = S.next(ui + 1, nxt);
        const char* nA = has_next ? (const char*)g.A + (size_t)nxt.pm * tstep : cA; const char* nB = has_next ? (const char*)g.Bt + (size_t)nxt.pn * tstep : cB;
        for (int t = 0; t < nt; t += 2) {
            const bool last = (t == nt - 2);
            const char* a1 = cA + (size_t)(t + 1) * kstep;
            const char* a2 = last ? nA : cA + (size_t)(t + 2) * kstep; const char* b2 = last ? nB : cB + (size_t)(t + 2) * kstep;
            const char* a3 = a2 + kstep; const char* b3 = b2 + kstep;
            if (last && has_next) S.a_ready(nxt);
            if constexpr (SP2) {
            PG8_LDB(B0, 0, 0); PG8_LDB(B1, 0, 1); PG8_SCHED; PG8_LDA(At, 0, 0); PG8_STAGE(PG8_SA(1, 1), a1 + hstep, voffA);
            PG8_WAIT_V(8); PG8_WAIT_L(0); PG8_BAR; PG8_MMA(0, 0, At, B0); PG8_MMA(0, 1, At, B1); PG8_BAR; PG8_SCHED;
            PG8_LDA(At, 0, 1); PG8_STAGE(PG8_SB(0, 0), b2, voffB); PG8_STAGE(PG8_SB(0, 1), b2 + hstep, voffB); PG8_STAGE(PG8_SA(0, 0), a2, voffA);
            PG8_WAIT_V(8); PG8_WAIT_L(0); PG8_BAR; PG8_MMA(1, 0, At, B0); PG8_MMA(1, 1, At, B1); PG8_BAR; PG8_SCHED;
            PG8_LDB(B0, 1, 0); PG8_LDB(B1, 1, 1); PG8_SCHED; PG8_LDA(At, 1, 0); PG8_STAGE(PG8_SA(0, 1), a2 + hstep, voffA);
            PG8_WAIT_V(8); PG8_WAIT_L(0); PG8_BAR; PG8_MMA(0, 0, At, B0); PG8_MMA(0, 1, At, B1); PG8_BAR; PG8_SCHED;
            PG8_LDA(At, 1, 1); PG8_STAGE(PG8_SB(1, 0), b3, voffB); PG8_STAGE(PG8_SB(1, 1), b3 + hstep, voffB); PG8_STAGE(PG8_SA(1, 0), a3, voffA);
            PG8_WAIT_V(8); PG8_WAIT_L(0); PG8_BAR; PG8_MMA(1, 0, At, B0); PG8_MMA(1, 1, At, B1); PG8_BAR; PG8_SCHED;
            } else {
            PG8_LDB(B0, 0, 0); PG8_SCHED; PG8_LDA(At, 0, 0); PG8_STAGE(PG8_SA(1, 1), a1 + hstep, voffA);
            PG8_WAIT_L(8); PG8_BAR; PG8_WAIT_L(0); PG8_MMA(0, 0, At, B0); PG8_BAR; PG8_SCHED;
            PG8_LDB(B1, 0, 1); PG8_STAGE(PG8_SB(0, 0), b2, voffB);
            PG8_BAR; PG8_WAIT_L(0); PG8_MMA(0, 1, At, B1); PG8_BAR;
            PG8_LDA(At, 0, 1); PG8_STAGE(PG8_SA(0, 0), a2, voffA);
            PG8_BAR; PG8_WAIT_L(0); PG8_MMA(1, 0, At, B0); PG8_BAR; PG8_SCHED;
            PG8_STAGE(PG8_SB(0, 1), b2 + hstep, voffB);
            PG8_WAIT_V(6); PG8_BAR; PG8_MMA(1, 1, At, B1); PG8_BAR;
            PG8_LDB(B0, 1, 0); PG8_SCHED; PG8_LDA(At, 1, 0); PG8_STAGE(PG8_SA(0, 1), a2 + hstep, voffA);
            PG8_WAIT_L(8); PG8_BAR; PG8_WAIT_L(0); PG8_MMA(0, 0, At, B0); PG8_BAR; PG8_SCHED;
            PG8_LDB(B1, 1, 1); PG8_STAGE(PG8_SB(1, 0), b3, voffB);
            PG8_BAR; PG8_WAIT_L(0); PG8_MMA(0, 1, At, B1); PG8_BAR;
            PG8_LDA(At, 1, 1); PG8_STAGE(PG8_SA(1, 0), a3, voffA);
            PG8_BAR; PG8_WAIT_L(0); PG8_MMA(1, 0, At, B0); PG8_BAR; PG8_SCHED;
            PG8_STAGE(PG8_SB(1, 1), b3 + hstep, voffB);
            PG8_WAIT_V(6); PG8_BAR; PG8_MMA(1, 1, At, B1); PG8_BAR;
            }
        }
        if constexpr (ALIGN_EPI) { if (wr == 0) PG8_BAR; }
        if constexpr (!Epi::AFTER_DRAIN) { E(acc, cur, wr, wc, fr, fq); S.done(cur); }
        if (!has_next) break;
#pragma unroll
        for (int a = 0; a < 2; ++a)
#pragma unroll
            for (int b = 0; b < 2; ++b)
#pragma unroll
                for (int m = 0; m < 4; ++m)
#pragma unroll
                    for (int n = 0; n < 2; ++n) acc[a][b][m][n] = (f32x4){0.f, 0.f, 0.f, 0.f};
        cur = nxt; cA = nA; cB = nB; ++ui;
        if constexpr (ALIGN_EPI) { if (wr == 1) PG8_BAR; }
    }
    PG8_WAIT_V(0);
    if constexpr (!ALIGN_EPI) { if (wr == 0) PG8_BAR; }
    PG8_BAR;
    if constexpr (Epi::AFTER_DRAIN) { E.fused(acc, cur, wr, wc, fr, fq, lds, wid, lane); S.done(cur); }
#undef PG8_SA
#undef PG8_SB
#undef PG8_STAGE
#undef PG8_LDA
#undef PG8_LDB
#undef PG8_MMA
#undef PG8_WAIT_V
#undef PG8_WAIT_L
#undef PG8_BAR
#undef PG8_SCHED
}
}

constexpr int NB = 16, SEQ = 2048, CTXL = 256, DM = 1024, DFF = 4096;
constexpr int NX = NB * SEQ, NC = NB * CTXL, NTOK = NX + NC;
constexpr int INC = 3840;
constexpr int C_RQ = 0, C_RK = 512, C_RV = 1024, C_RG = 1536;
constexpr int C_WR = 2048, C_WK = 2560, C_WV = 3072, C_WL = 3584, C_AL = 3648, C_GL = 3712;
constexpr int ADA_LD = 6 * DM;
constexpr int NWAVES = 8;
constexpr size_t MiB = 1u << 20;
constexpr size_t WS_CTL = 0;
constexpr size_t WS_ADA = 1 * MiB;
constexpr size_t WS_ROPE = 1 * MiB + 512 * 1024;
constexpr size_t WS_SS = 256 * 1024;
constexpr size_t WS_CMAT = 30 * MiB;
constexpr size_t WS_BONUS = 2 * MiB;
constexpr size_t WS_GUPT = 3 * MiB;
constexpr size_t WS_WIN = 4 * MiB, WS_WOUT = 12 * MiB, WS_W1 = 14 * MiB, WS_W2 = 22 * MiB;
constexpr size_t WS_P = 32 * MiB;
constexpr size_t WS_XN = 304 * MiB;
constexpr size_t WS_YF = 304 * MiB, WS_YB = 336 * MiB;
constexpr size_t WS_MIXA = 376 * MiB;
constexpr size_t WS_OF = 440 * MiB, WS_OB = 472 * MiB;
constexpr size_t WS_XN2 = 440 * MiB;
constexpr size_t WS_END = 504 * MiB;
constexpr int LDS_BYTES = 155648;

typedef unsigned short bf16;
typedef unsigned v4u __attribute__((ext_vector_type(4)));
typedef unsigned v2u __attribute__((ext_vector_type(2)));
typedef float f32x4 __attribute__((ext_vector_type(4)));
typedef float f32x2 __attribute__((ext_vector_type(2)));
typedef short bf16x8 __attribute__((ext_vector_type(8)));

typedef __bf16 bf2_t __attribute__((ext_vector_type(2)));
__device__ __forceinline__ unsigned cvt2bf(float a, float b) { const f32x2 v = {a, b}; return __builtin_bit_cast(unsigned, __builtin_convertvector(v, bf2_t)); }
__device__ __forceinline__ unsigned f2bf(float f) { return cvt2bf(f, 0.f) & 0xffffu; }
__device__ __forceinline__ unsigned pk2(float lo, float hi) { return cvt2bf(lo, hi); }
__device__ __forceinline__ float bflo(unsigned u) { return __builtin_bit_cast(float, u << 16); }
__device__ __forceinline__ float bfhi(unsigned u) { return __builtin_bit_cast(float, u & 0xffff0000u); }
__device__ __forceinline__ void unpack8(const v4u w, float (&f)[8]) { f[0] = bflo(w.x); f[1] = bfhi(w.x); f[2] = bflo(w.y); f[3] = bfhi(w.y); f[4] = bflo(w.z); f[5] = bfhi(w.z); f[6] = bflo(w.w); f[7] = bfhi(w.w); }
__device__ __forceinline__ v4u pack8(const float (&f)[8]) { v4u w; w.x = pk2(f[0], f[1]); w.y = pk2(f[2], f[3]); w.z = pk2(f[4], f[5]); w.w = pk2(f[6], f[7]); return w; }
__device__ __forceinline__ void ld8f(const float* p, float (&f)[8]) { const f32x4 a = *(const f32x4*)p, b = *(const f32x4*)(p + 4); f[0] = a.x; f[1] = a.y; f[2] = a.z; f[3] = a.w; f[4] = b.x; f[5] = b.y; f[6] = b.z; f[7] = b.w; }
__device__ __forceinline__ float sigmoidf_(float x) { return __builtin_amdgcn_rcpf(1.f + __expf(-x)); }
template <int CTRL> __device__ __forceinline__ float dpp_mov(float x) { return __builtin_bit_cast(float, __builtin_amdgcn_update_dpp(0, __builtin_bit_cast(int, x), CTRL, 0xf, 0xf, false)); }
__device__ __forceinline__ float red8(float x) { x += dpp_mov<0xB1>(x); x += dpp_mov<0x4E>(x); x += dpp_mov<0x141>(x); return x; }
__device__ __forceinline__ float red16(float x) { x = red8(x); x += dpp_mov<0x128>(x); return x; }
__device__ __forceinline__ float wave_sum(float v) {
#pragma unroll
    for (int o = 1; o < 64; o <<= 1) v += __shfl_xor(v, o);
    return v;
}
__device__ __forceinline__ bf16x8 ldfrag(const unsigned char* base, int stride_bytes, int row0, int k0, int lane) {
    return *(const bf16x8*)(base + (row0 + (lane & 15)) * stride_bytes + (k0 + (lane >> 4) * 8) * 2);
}
#define MFMA16(a, b, c) __builtin_amdgcn_mfma_f32_16x16x32_bf16((a), (b), (c), 0, 0, 0)

struct Frame {
    unsigned char* lds;
    int tid, lane, wave, G, bid;
    const float* in[27];
    float* out; unsigned char* ws;
};

__device__ __forceinline__ void p0_transpose_item(const float* W, int K, int N, bf16* WT, float* scr, int item, int lane) {
    const int nblk = N / 32, kb = item / nblk, nb = item % nblk, k0 = 64 * kb, n0 = 32 * nb;
#pragma unroll 8
    for (int i = 0; i < 32; ++i) { const int kk = 2 * i + (lane >> 5); scr[kk * 33 + (lane & 31)] = W[(size_t)(k0 + kk) * N + n0 + (lane & 31)]; }
    asm volatile("s_waitcnt lgkmcnt(0)" ::: "memory");
    const int c = lane & 7;
#pragma unroll
    for (int j = 0; j < 4; ++j) { const int n = (lane >> 3) + 8 * j; const float* s = scr + (8 * c) * 33 + n;
        v4u o; o.x = pk2(s[0 * 33], s[1 * 33]); o.y = pk2(s[2 * 33], s[3 * 33]); o.z = pk2(s[4 * 33], s[5 * 33]); o.w = pk2(s[6 * 33], s[7 * 33]);
        *(v4u*)(WT + (size_t)(n0 + n) * K + k0 + 8 * c) = o; }
    asm volatile("s_waitcnt lgkmcnt(0)" ::: "memory");
}
__device__ __forceinline__ void p0_phase(Frame& F) {
    float* cs = (float*)F.lds;
    float* red = (float*)(F.lds + 71680);
    const float* c = F.in[1]; const float* c_ctx = F.in[3]; const float* w_ada = F.in[4]; const float* b_ada = F.in[5];
    float* ADA = (float*)(F.ws + WS_ADA);
    bool staged = false;
    for (int cb = F.bid; cb < 192; cb += F.G) {
        if (!staged) {
            for (int idx = F.tid; idx < 17 * 1024; idx += 512) { const int r = idx >> 10, k = idx & 1023; const float v = (r < 16) ? c[r * 1024 + k] : c_ctx[k]; cs[idx] = v / (1.f + __expf(-v)); }
            staged = true;
        }
        __syncthreads();
        const int col = F.tid & 31, kp = F.tid >> 5;
        float acc[17];
#pragma unroll
        for (int r = 0; r < 17; ++r) acc[r] = 0.f;
        const float* wp = w_ada + (size_t)(kp * 64) * ADA_LD + cb * 32 + col;
#pragma unroll 4
        for (int kk = 0; kk < 64; ++kk) { const float w = wp[(size_t)kk * ADA_LD]; const int k = kp * 64 + kk;
#pragma unroll
            for (int r = 0; r < 17; ++r) acc[r] += cs[r * 1024 + k] * w; }
#pragma unroll
        for (int r = 0; r < 17; ++r) red[(kp * 17 + r) * 32 + col] = acc[r];
        __syncthreads();
        for (int idx = F.tid; idx < 17 * 32; idx += 512) { const int r = idx >> 5, cc = idx & 31; float s = 0.f;
#pragma unroll
            for (int q = 0; q < 16; ++q) s += red[(q * 17 + r) * 32 + cc];
            ADA[r * ADA_LD + cb * 32 + cc] = s + b_ada[cb * 32 + cc]; }
    }
    __syncthreads();
    if (F.bid == F.G - 1) {
        float* rc = (float*)(F.ws + WS_ROPE); float* rs = rc + 2048;
        for (int idx = F.tid; idx < 2048; idx += 512) { const int pos = idx >> 5, f = idx & 31;
            const float inv = exp2f(-(float)(2 * f) * (13.287712379549449f / 64.f));
            const float ang = (float)pos * inv; float rev = ang * 0.15915494309189535f; rev = rev - floorf(rev);
            rc[idx] = __builtin_amdgcn_cosf(rev); rs[idx] = __builtin_amdgcn_sinf(rev); }
    }
    float* scr = (float*)(F.lds + F.wave * 16384);
    const int gw = F.bid * NWAVES + F.wave, NGW = F.G * NWAVES;
    constexpr int I_IN = (DM / 64) * (INC / 32), I_OUT = (DM / 64) * (DM / 32), I_1 = (DM / 64) * (DFF / 32), I_2 = (DFF / 64) * (DM / 32), I_G = (128 / 64) * (512 / 32);
    (void)I_OUT; (void)I_1; (void)I_2;
    for (int it = gw; it < I_IN + I_G; it += NGW) {
        if (it < I_IN) p0_transpose_item(F.in[8], DM, INC, (bf16*)(F.ws + WS_WIN), scr, it, F.lane);
        else p0_transpose_item(F.in[15], 128, 512, (bf16*)(F.ws + WS_GUPT), scr, it - I_IN, F.lane);
    }
}
__device__ __forceinline__ void wconv_tail(Frame& F, int first_bid) {
    if (F.bid < first_bid) return;
    float* scr = (float*)(F.lds + F.wave * 16384);
    const int gw = (F.bid - first_bid) * NWAVES + F.wave, NGW = (F.G - first_bid) * NWAVES;
    constexpr int I_OUT = (DM / 64) * (DM / 32), I_1 = (DM / 64) * (DFF / 32), I_2 = (DFF / 64) * (DM / 32);
    for (int it = gw; it < I_OUT + I_1 + I_2; it += NGW) {
        int r = it;
        if (r < I_OUT) { p0_transpose_item(F.in[21], DM, DM, (bf16*)(F.ws + WS_WOUT), scr, r, F.lane); continue; } r -= I_OUT;
        if (r < I_1) { p0_transpose_item(F.in[22], DM, DFF, (bf16*)(F.ws + WS_W1), scr, r, F.lane); continue; } r -= I_1;
        p0_transpose_item(F.in[24], DFF, DM, (bf16*)(F.ws + WS_W2), scr, r, F.lane);
    }
}

template <int MODE> __device__ __forceinline__ void norm_phase(Frame& F) {
    const int gw = F.bid * NWAVES + F.wave, NGW = F.G * NWAVES;
    const float* ADA = (const float*)(F.ws + WS_ADA);
    const float* gam = MODE == 0 ? F.in[6] : (MODE == 1 ? F.in[7] : F.in[26]);
    const int nrows = MODE == 0 ? NTOK : NX;
    f32x4 g4[4];
#pragma unroll
    for (int j = 0; j < 4; ++j) g4[j] = *(const f32x4*)(gam + j * 256 + F.lane * 4);
    const int per = (nrows + NGW - 1) / NGW, m_end = (gw + 1) * per < nrows ? (gw + 1) * per : nrows;
    int bcur = -1; f32x4 sg[4], sh[4];
    for (int m = gw * per; m < m_end; m += 2) {
        const float* src; int b;
        if (MODE == 0) { if (m < NX) { src = F.in[0] + (size_t)m * DM; b = m >> 11; } else { src = F.in[2] + (size_t)(m - NX) * DM; b = 16; } }
        else { src = F.out + (size_t)m * DM; b = m >> 11; }
        f32x4 v[4], u[4]; float s = 0.f, t = 0.f;
#pragma unroll
        for (int j = 0; j < 4; ++j) { v[j] = __builtin_nontemporal_load((const f32x4*)(src + j * 256 + F.lane * 4)); u[j] = __builtin_nontemporal_load((const f32x4*)(src + DM + j * 256 + F.lane * 4)); }
#pragma unroll
        for (int j = 0; j < 4; ++j) { s += (v[j].x * v[j].x + v[j].y * v[j].y) + (v[j].z * v[j].z + v[j].w * v[j].w); t += (u[j].x * u[j].x + u[j].y * u[j].y) + (u[j].z * u[j].z + u[j].w * u[j].w); }
        if (MODE != 2 && b != bcur) {
            const float* ar = ADA + (size_t)b * ADA_LD + (MODE == 0 ? 0 : 3 * DM); bcur = b;
#pragma unroll
            for (int j = 0; j < 4; ++j) { const int col = j * 256 + F.lane * 4; sh[j] = *(const f32x4*)(ar + col); sg[j] = g4[j] * (*(const f32x4*)(ar + DM + col) + 1.0f); }
        }
        const float rs = 1.0f / sqrtf(wave_sum(s) * (1.f / DM) + 1e-6f), rt = 1.0f / sqrtf(wave_sum(t) * (1.f / DM) + 1e-6f);
        if (MODE == 2) {
#pragma unroll
            for (int j = 0; j < 4; ++j) { __builtin_nontemporal_store(v[j] * rs * g4[j], (f32x4*)(F.out + (size_t)m * DM + j * 256 + F.lane * 4));
                __builtin_nontemporal_store(u[j] * rt * g4[j], (f32x4*)(F.out + (size_t)(m + 1) * DM + j * 256 + F.lane * 4)); }
        } else {
            bf16* dst = (bf16*)(F.ws + (MODE == 0 ? WS_XN : WS_XN2)) + (size_t)m * DM;
#pragma unroll
            for (int j = 0; j < 4; ++j) { const int col = j * 256 + F.lane * 4;
                const f32x4 y = v[j] * rs * sg[j] + sh[j], z = u[j] * rt * sg[j] + sh[j];
                v2u o; o.x = pk2(y.x, y.y); o.y = pk2(y.z, y.w); *(v2u*)(dst + col) = o;
                v2u q; q.x = pk2(z.x, z.y); q.y = pk2(z.z, z.w); *(v2u*)(dst + DM + col) = q; }
        }
    }
}

__device__ __forceinline__ void cmat_phase(Frame& F) {
    float* cs = (float*)F.lds;
    float* red = (float*)(F.lds + 65536);
    const float* ADA = (const float*)(F.ws + WS_ADA); const float* w1 = F.in[22]; const float* b1 = F.in[23];
    float* CM = (float*)(F.ws + WS_CMAT);
    bool staged = false;
    for (int cb = F.bid; cb < 128; cb += F.G) {
        if (!staged) { for (int idx = F.tid; idx < 16 * 1024; idx += 512) cs[idx] = ADA[(size_t)(idx >> 10) * ADA_LD + 3 * DM + (idx & 1023)]; staged = true; }
        __syncthreads();
        const int col = F.tid & 31, kp = F.tid >> 5;
        float acc[16];
#pragma unroll
        for (int r = 0; r < 16; ++r) acc[r] = 0.f;
        const float* wp = w1 + (size_t)(kp * 64) * DFF + cb * 32 + col;
#pragma unroll 4
        for (int kk = 0; kk < 64; ++kk) { const float w = wp[(size_t)kk * DFF]; const int k = kp * 64 + kk;
#pragma unroll
            for (int r = 0; r < 16; ++r) acc[r] += cs[r * 1024 + k] * w; }
#pragma unroll
        for (int r = 0; r < 16; ++r) red[(kp * 16 + r) * 32 + col] = acc[r];
        __syncthreads();
        { const int r = F.tid >> 5, cc = F.tid & 31; float s = 0.f;
#pragma unroll
          for (int q = 0; q < 16; ++q) s += red[(q * 16 + r) * 32 + cc];
          CM[r * DFF + cb * 32 + cc] = s + b1[cb * 32 + cc]; }
    }
    __syncthreads();
}

constexpr int RWC = 32;
constexpr int RW_W = 0, RW_B = 8192, RW_KT = 16384, RW_KKI = 24576, RW_RI = 28672, RW_R = 32768, RW_V = 40960, RW_BUF = 49152;
constexpr int RW_Y = 98304, RW_A = 114688, RW_UP = 123904, RW_PAR = RW_UP + 18432 + 768;
constexpr int RW_TSTRIDE = 144;
constexpr int RW_PCNT = RW_UP + 18432 + 768 + 2816 + 8704;
constexpr int RW_ZERO = RW_UP + 18432 + 768 + 2816;
__device__ __forceinline__ int rw_perm(int k) { const int t = k >> 4, g = (k >> 2) & 3, j = k & 3; return (t >> 1) * 32 + g * 8 + (t & 1) * 4 + j; }
struct RwPos { int woff, bkoff, voff, ap, yo; };
struct RwOps { v4u A2[4]; f32x4 w[4]; float v; };
__device__ __forceinline__ void rw_ld_ops(const unsigned char* L, const RwPos& P, RwOps& o) {
#pragma unroll
    for (int t = 0; t < 4; ++t) { o.w[t] = *(const f32x4*)(L + P.woff + t * 64); o.A2[t].x = *(const unsigned*)(L + P.bkoff + t * 64); }
    o.v = *(const float*)(L + P.voff);
}
__device__ __forceinline__ void rw_update(f32x4 (&St)[4], RwOps& o, v4u& B2, const float rem) {
    B2.x = cvt2bf(rem, o.v);
    asm("" : "+v"(B2));
#pragma unroll
    for (int t = 0; t < 4; ++t) asm("" : "+v"(o.A2[t]));
#pragma unroll
    for (int t = 0; t < 4; ++t) St[t] = MFMA16(__builtin_bit_cast(bf16x8, o.A2[t]), __builtin_bit_cast(bf16x8, B2), St[t] * o.w[t]);
}
__device__ __forceinline__ f32x4 rw_readout(const f32x4 (&St)[4], const bf16x8 a0, const bf16x8 a1) {
    v4u b0, b1;
    b0.x = cvt2bf(St[0].x, St[0].y); b0.y = cvt2bf(St[0].z, St[0].w); b0.z = cvt2bf(St[1].x, St[1].y); b0.w = cvt2bf(St[1].z, St[1].w);
    b1.x = cvt2bf(St[2].x, St[2].y); b1.y = cvt2bf(St[2].z, St[2].w); b1.z = cvt2bf(St[3].x, St[3].y); b1.w = cvt2bf(St[3].z, St[3].w);
    f32x4 acc = {0.f, 0.f, 0.f, 0.f};
    acc = MFMA16(a0, __builtin_bit_cast(bf16x8, b0), acc);
    acc = MFMA16(a1, __builtin_bit_cast(bf16x8, b1), acc);
    return acc;
}
template <bool INCL, bool WY> __device__ __forceinline__ void rw_scan_chunk(const unsigned char* Lin, const unsigned char* L, unsigned char* Ly, f32x4 (&St)[4], int wave, int lane) {
    const int n = lane & 15, g = lane >> 4, sel = lane & 3, lin = (int)(Lin - L), row = wave * 16 + n;
    const bool g0 = g == 0;
    RwPos P; P.woff = lin + RW_W + g * 16; P.bkoff = g0 ? lin + RW_B + n * 4 : RW_ZERO; P.voff = lin + RW_V + row * 4; P.yo = (int)(Ly - L) + row * 4;
    P.ap = sel == 0 ? lin + RW_KKI + g * 16 + (INCL ? 128 : 0) : (sel == 1 ? lin + RW_RI + g * 16 : RW_ZERO);
    constexpr int astep = 128, bkstep = 256;
    unsigned char* Lw = const_cast<unsigned char*>(L);
    RwOps O;
#pragma unroll
    for (int t = 0; t < 4; ++t) O.A2[t] = (v4u){0u, 0u, 0u, 0u};
    v4u B2 = {0u, 0u, 0u, 0u};
    float rem = 0.f;
    if (INCL) { const int f0p = P.ap - astep; rem = rw_readout(St, *(const bf16x8*)(L + f0p), *(const bf16x8*)(L + f0p + 64))[0]; }
    rw_ld_ops(L, P, O);
    bf16x8 ca0 = *(const bf16x8*)(L + P.ap), ca1 = *(const bf16x8*)(L + P.ap + 64);
#pragma unroll 4
    for (int i = 0; i < RWC; ++i) {
        P.woff += 256; P.bkoff += bkstep; P.voff += 256; P.ap += astep;
        float y;
        if (INCL) {
            rw_update(St, O, B2, rem);
            asm volatile("" ::: "memory");
            rw_ld_ops(L, P, O);
            const bf16x8 na0 = *(const bf16x8*)(L + P.ap), na1 = *(const bf16x8*)(L + P.ap + 64);
            const f32x4 acc = rw_readout(St, ca0, ca1); rem = acc[0]; y = acc[1];
            ca0 = na0; ca1 = na1;
        } else {
            const f32x4 acc = rw_readout(St, ca0, ca1); y = acc[1];
            ca0 = *(const bf16x8*)(L + P.ap); ca1 = *(const bf16x8*)(L + P.ap + 64);
            asm volatile("" ::: "memory");
            rw_update(St, O, B2, acc[0]);
            asm volatile("" ::: "memory");
            rw_ld_ops(L, P, O);
        }
        if (WY) { *(float*)(Lw + P.yo) = y; P.yo += 256; }
    }
}
__device__ __forceinline__ void rw_mfma_part(unsigned char* L, unsigned char* Lb, int wave, int lane) {
    const int mat = wave >> 2, nt = wave & 3, ecol = nt * 16 + (lane & 15);
    const unsigned char* LUP = L + RW_UP + mat * 9216;
    const bf16x8 bf0 = ldfrag(LUP, RW_TSTRIDE, nt * 16, 0, lane), bf1 = ldfrag(LUP, RW_TSTRIDE, nt * 16, 32, lane);
    const float bias0 = ((const float*)(L + RW_UP + 18432))[mat * 64 + ecol], kav = ((const float*)(L + RW_UP + 18432))[128 + ecol];
#pragma unroll
    for (int mt = 0; mt < 2; ++mt) {
        const unsigned char* A = L + RW_A + (mat * 2 + mt) * 2304;
        f32x4 acc = {0.f, 0.f, 0.f, 0.f};
        acc = MFMA16(ldfrag(A, RW_TSTRIDE, 0, 0, lane), bf0, acc);
        acc = MFMA16(ldfrag(A, RW_TSTRIDE, 0, 32, lane), bf1, acc);
#pragma unroll
        for (int j = 0; j < 4; ++j) { const int row = mt * 16 + (lane >> 4) * 4 + j; const int o4 = (row * 64 + ecol) * 4; const float z = acc[j] + bias0;
            if (mat == 0) { *(float*)(Lb + RW_W + o4) = __expf(-0.6065306597126334f * sigmoidf_(z)); }
            else { const float a = sigmoidf_(z); const float bv_ = bflo((unsigned)*(const bf16*)(Lb + RW_KKI + row * 128 + rw_perm(ecol) * 2)) * a;
                   const float kt_ = *(const float*)(Lb + RW_KT + o4) * (1.f + (a - 1.f) * kav);
                   *(float*)(Lb + RW_KT + o4) = kt_; *(unsigned*)(Lb + RW_B + o4) = pg8::cvt_pk_bf16(-bv_, kt_); } }
    }
}
__device__ __forceinline__ void rwkv_scan_unit(Frame& F, int sid) {
    asm volatile("" : "+v"(F.tid)); F.lane = F.tid & 63;
    const int b = sid >> 4, h = (sid >> 1) & 7, d = sid & 1, hc = h * 64;
    unsigned char* L = F.lds;
    constexpr int NCC = CTXL / RWC, NCH = NCC + SEQ / RWC;
#pragma unroll 4
    for (int q = 0; q < 16; ++q) { const int idx = F.tid + 512 * q; const int m_ = idx >> 12, k_ = (idx >> 6) & 63, n_ = idx & 63;
        *(bf16*)(L + RW_UP + m_ * 9216 + n_ * RW_TSTRIDE + k_ * 2) = (bf16)f2bf((m_ == 0 ? F.in[12] : F.in[14])[(size_t)d * 64 * 512 + (size_t)k_ * 512 + hc + n_]); }
#pragma unroll 1
    for (int idx = F.tid; idx < 704; idx += 512) { float v_;
        if (idx < 640) { const int g_ = idx >> 7, r_ = (idx >> 6) & 1, n_ = idx & 63; const int cb_ = g_ == 0 ? C_WL : (g_ == 1 ? C_AL : (g_ == 2 ? C_WR + hc : (g_ == 3 ? C_WK + hc : C_WV + hc))); v_ = F.in[10][r_ * 1792 + (cb_ - 2048) + n_]; }
        else v_ = F.in[16][hc + (idx - 640)];
        ((float*)(L + RW_PAR))[idx] = v_; }
    if (F.tid == 0) *(unsigned*)(L + RW_PCNT) = 0u;
    if (F.tid < 64) ((float*)(L + RW_PCNT + 16))[F.tid] = F.in[18][hc + F.tid];
    for (int idx = F.tid; idx < 2176; idx += 512) ((unsigned*)(L + RW_ZERO))[idx] = 0u;
    if (F.tid < 192) { const int wh_ = F.tid >> 6, n_ = F.tid & 63; ((float*)(L + RW_UP + 18432))[F.tid] = wh_ == 0 ? F.in[11][d * 512 + hc + n_] : (wh_ == 1 ? F.in[13][d * 512 + hc + n_] : F.in[17][hc + n_]); }
    __syncthreads();
    if (F.wave < 4) {
        f32x4 X[4];
#pragma unroll
        for (int j = 0; j < 4; ++j) X[j] = (f32x4){0.f, 0.f, 0.f, 0.f};
        __syncthreads();
        for (int c = 0; c < NCH; ++c) {
            if (c > NCC) {
                const int fi = F.tid >> 3, fc8 = (F.tid & 7) * 8;
                const int s = (c - 1 - NCC) * RWC + fi, t = d ? SEQ - 1 - s : s;
                const unsigned char* Lyp = L + RW_Y + ((c - 1) & 1) * 8192;
                const f32x4 y0 = *(const f32x4*)(Lyp + (fi * 64 + fc8) * 4), y1 = *(const f32x4*)(Lyp + (fi * 64 + fc8 + 4) * 4);
                v4u o; o.x = pk2(y0.x, y0.y); o.y = pk2(y0.z, y0.w); o.z = pk2(y1.x, y1.y); o.w = pk2(y1.z, y1.w);
                *(v4u*)((bf16*)(F.ws + (d == 0 ? WS_YF : WS_YB)) + ((size_t)b * SEQ + t) * 512 + hc + fc8) = o;
            }
            if (d == 0 && c >= NCC) {
                const int fi = F.tid >> 3, fc8 = (F.tid & 7) * 8;
                const unsigned char* Lb = L + (c & 1) * RW_BUF; const int o4 = (fi * 64 + fc8) * 4;
                const f32x4 r0 = *(const f32x4*)(Lb + RW_R + o4), r1 = *(const f32x4*)(Lb + RW_R + o4 + 16), t0 = *(const f32x4*)(Lb + RW_KT + o4), t1 = *(const f32x4*)(Lb + RW_KT + o4 + 16);
                const f32x4 rk0 = *(const f32x4*)(L + RW_PCNT + 16 + fc8 * 4), rk1 = *(const f32x4*)(L + RW_PCNT + 16 + fc8 * 4 + 16);
                const f32x4 p0 = r0 * t0 * rk0, p1 = r1 * t1 * rk1;
                const float s = red8((p0.x + p0.y) + (p0.z + p0.w) + (p1.x + p1.y) + (p1.z + p1.w));
                if ((F.tid & 7) == 0) { const int t = (c - NCC) * RWC + fi; ((float*)(F.ws + WS_BONUS))[((size_t)b * SEQ + t) * 8 + h] = s; }
            }
            const unsigned char* Lin = L + (c & 1) * RW_BUF; unsigned char* Ly = L + RW_Y + (c & 1) * 8192;
            if (d == 0) { if (c >= NCC) rw_scan_chunk<true, true>(Lin, L, Ly, X, F.wave, F.lane); else rw_scan_chunk<true, false>(Lin, L, Ly, X, F.wave, F.lane); }
            else        { if (c >= NCC) rw_scan_chunk<false, true>(Lin, L, Ly, X, F.wave, F.lane); else rw_scan_chunk<false, false>(Lin, L, Ly, X, F.wave, F.lane); }
            __syncthreads();
        }
    } else {
        const bf16* P = (const bf16*)(F.ws + WS_P);
        const float* mu = F.in[10];
        const int p = F.wave - 4, mt = p & 1, mat = p >> 1, lane = F.lane, tid2 = F.tid - 256;
        const int row16 = lane >> 2, c16 = (lane & 3) * 16, irow = mt * 16 + row16;
        const int na = mat ? 2 : 3;
        const int colb[3] = {mat ? C_AL : C_WL, mat ? C_WK + hc : C_WR + hc, C_WV + hc};
        unsigned char* LA = L + RW_A + p * 2304;
        const unsigned char* LUP = L + RW_UP + mat * 9216;
        const float* biasp = (const float*)(L + RW_UP + 18432) + mat * 64 + (lane & 15); const float* kavp = (const float*)(L + RW_UP + 18432) + 128 + (lane & 15);
        const int bi = tid2 >> 3, bc8 = (tid2 & 7) * 8;
        float* BON = (float*)(F.ws + WS_BONUS);
        bf16* Yd = (bf16*)(F.ws + (d == 0 ? WS_YF : WS_YB));
        v4u raw[3][3][2];
#define RW_LOAD_RAW(c) do { const bool xph_ = (c) >= NCC; const int T_ = xph_ ? SEQ : CTXL; const int cc_ = xph_ ? (c) - NCC : (c); \
        const size_t base_ = xph_ ? (size_t)b * SEQ : (size_t)NX + (size_t)b * CTXL; const int s_ = cc_ * RWC + irow; const int t_ = d ? T_ - 1 - s_ : s_; \
        const bf16* pr_ = P + (base_ + t_) * INC + c16; \
        _Pragma("unroll") for (int a = 0; a < 3; ++a) if (a < na) { \
            raw[a][1][0] = *(const v4u*)(pr_ + colb[a]); raw[a][1][1] = *(const v4u*)(pr_ + colb[a] + 8); \
            if (t_ > 0) { raw[a][0][0] = *(const v4u*)(pr_ - INC + colb[a]); raw[a][0][1] = *(const v4u*)(pr_ - INC + colb[a] + 8); } else { raw[a][0][0] = (v4u){0u, 0u, 0u, 0u}; raw[a][0][1] = (v4u){0u, 0u, 0u, 0u}; } \
            if (t_ < T_ - 1) { raw[a][2][0] = *(const v4u*)(pr_ + INC + colb[a]); raw[a][2][1] = *(const v4u*)(pr_ + INC + colb[a] + 8); } else { raw[a][2][0] = (v4u){0u, 0u, 0u, 0u}; raw[a][2][1] = (v4u){0u, 0u, 0u, 0u}; } } } while (0)
#define RW_PREP(c) do { unsigned char* Lb_ = L + ((c) & 1) * RW_BUF; \
        _Pragma("unroll") for (int a = 0; a < 3; ++a) if (a < na) { \
            _Pragma("unroll") for (int hf = 0; hf < 2; ++hf) { \
                float pc_[8], pp_[8], pn_[8], m0_[8], m1_[8], sv_[8]; \
                unpack8(raw[a][1][hf], pc_); unpack8(raw[a][0][hf], pp_); unpack8(raw[a][2][hf], pn_); \
                const float* mp_ = (const float*)(L + RW_PAR) + (mat ? (a == 0 ? 1 : 3) : (a == 0 ? 0 : (a == 1 ? 2 : 4))) * 128 + c16 + hf * 8; ld8f(mp_, m0_); ld8f(mp_ + 64, m1_); \
                _Pragma("unroll") for (int j = 0; j < 8; ++j) sv_[j] = pc_[j] + m0_[j] * (pp_[j] - pc_[j]) + m1_[j] * (pn_[j] - pc_[j]); \
                if (a == 0) { \
                    if (mat == 0) { _Pragma("unroll") for (int j = 0; j < 8; ++j) { const float e_ = __expf(2.f * sv_[j]); sv_[j] = 1.f - 2.f * __builtin_amdgcn_rcpf(e_ + 1.f); } } \
                    *(v4u*)(LA + row16 * RW_TSTRIDE + (c16 + hf * 8) * 2) = pack8(sv_); \
                } else if (a == 1 && mat == 0) { \
                    { const int pb_ = irow * 128 + rw_perm(c16 + hf * 8) * 2; v2u lo_, hi_; lo_.x = pk2(sv_[0], sv_[1]); lo_.y = pk2(sv_[2], sv_[3]); hi_.x = pk2(sv_[4], sv_[5]); hi_.y = pk2(sv_[6], sv_[7]); \
                      *(v2u*)(Lb_ + RW_RI + pb_) = lo_; *(v2u*)(Lb_ + RW_RI + pb_ + 16) = hi_; } \
                    *(f32x4*)(Lb_ + RW_R + (irow * 64 + c16 + hf * 8) * 4) = (f32x4){sv_[0], sv_[1], sv_[2], sv_[3]}; *(f32x4*)(Lb_ + RW_R + (irow * 64 + c16 + hf * 8 + 4) * 4) = (f32x4){sv_[4], sv_[5], sv_[6], sv_[7]}; \
                } else if (a == 2) { \
                    *(f32x4*)(Lb_ + RW_V + (irow * 64 + c16 + hf * 8) * 4) = (f32x4){sv_[0], sv_[1], sv_[2], sv_[3]}; *(f32x4*)(Lb_ + RW_V + (irow * 64 + c16 + hf * 8 + 4) * 4) = (f32x4){sv_[4], sv_[5], sv_[6], sv_[7]}; \
                } else { \
                    *(f32x4*)(Lb_ + RW_KT + (irow * 64 + c16 + hf * 8) * 4) = (f32x4){sv_[0], sv_[1], sv_[2], sv_[3]}; *(f32x4*)(Lb_ + RW_KT + (irow * 64 + c16 + hf * 8 + 4) * 4) = (f32x4){sv_[4], sv_[5], sv_[6], sv_[7]};   \
                    float kk_[8]; ld8f((const float*)(L + RW_PAR) + 640 + c16 + hf * 8, kk_); \
                    _Pragma("unroll") for (int j = 0; j < 8; ++j) { krv[hf * 8 + j] = sv_[j] * kk_[j]; kss += krv[hf * 8 + j] * krv[hf * 8 + j]; } \
                } } } \
        if (mat == 1) { kss += dpp_mov<0xB1>(kss); kss += dpp_mov<0x4E>(kss); const float rn_ = __builtin_amdgcn_rsqf(kss + 1e-12f); \
            _Pragma("unroll") for (int q = 0; q < 4; ++q) { v2u w_; w_.x = pk2(krv[q * 4] * rn_, krv[q * 4 + 1] * rn_); w_.y = pk2(krv[q * 4 + 2] * rn_, krv[q * 4 + 3] * rn_); *(v2u*)(Lb_ + RW_KKI + irow * 128 + rw_perm(c16 + q * 4) * 2) = w_; } } \
        asm volatile("s_waitcnt lgkmcnt(0)" ::: "memory"); } while (0)
        float krv[16]; float kss;
#define RW_PSYNC(k) do { asm volatile("s_waitcnt lgkmcnt(0)" ::: "memory"); \
            if (lane == 0) __hip_atomic_fetch_add((unsigned*)(L + RW_PCNT), 1u, __ATOMIC_RELAXED, __HIP_MEMORY_SCOPE_WORKGROUP); \
            while (*(const volatile __attribute__((address_space(3))) unsigned*)(unsigned)(RW_PCNT) < 4u * (unsigned)(k)) __builtin_amdgcn_s_sleep(1); \
            asm volatile("" ::: "memory"); } while (0)
#define RW_PMFMA(Lb) do { const int vw_ = (p >> 1) * 4 + (p & 1) * 2; rw_mfma_part(L, (Lb), vw_, lane); rw_mfma_part(L, (Lb), vw_ + 1, lane); } while (0)
        RW_LOAD_RAW(0);
        kss = 0.f; RW_PREP(0);
        RW_PSYNC(1);
        RW_PMFMA(L);
        RW_LOAD_RAW(1);
        __syncthreads();
        for (int c = 0; c < NCH; ++c) {
            if (c + 1 < NCH) { kss = 0.f; RW_PREP(c + 1); RW_PSYNC(c + 2); RW_PMFMA(L + ((c + 1) & 1) * RW_BUF); }
            if (c + 2 < NCH) RW_LOAD_RAW(c + 2);
            __syncthreads();
        }
        {
            const int s = (NCH - 1 - NCC) * RWC + bi, t = d ? SEQ - 1 - s : s;
            const unsigned char* Ly = L + RW_Y + ((NCH - 1) & 1) * 8192;
            const f32x4 y0 = *(const f32x4*)(Ly + (bi * 64 + bc8) * 4), y1 = *(const f32x4*)(Ly + (bi * 64 + bc8 + 4) * 4);
            v4u o; o.x = pk2(y0.x, y0.y); o.y = pk2(y0.z, y0.w); o.z = pk2(y1.x, y1.y); o.w = pk2(y1.z, y1.w);
            *(v4u*)(Yd + ((size_t)b * SEQ + t) * 512 + hc + bc8) = o;
        }
#undef RW_LOAD_RAW
#undef RW_PREP
    }
    __syncthreads();
}

constexpr int RT_Q = 0, RT_K = 17408, RT_KT = 34816, RT_VT = 53248, RT_STG = 62464  , RT_P = 2 * RT_STG, RT_ST = RT_P + 9216, RT_END = RT_ST + 17408;
constexpr int RT_S136 = 272, RT_S72 = 144;
static_assert(RT_END <= LDS_BYTES, "retention LDS map");
__device__ __forceinline__ void ret_unit(Frame& F, int rid) {
    const int b = rid >> 4, h = (rid >> 2) & 3, dir = (rid >> 1) & 1, half = rid & 1;
    unsigned char* L = F.lds;
    const bf16* P = (const bf16*)(F.ws + WS_P);
    const float lg2 = -__expf(F.in[9][dir * 4 + h]) * 1.4426950408889634f;
    const float* rope_c = (const float*)(F.ws + WS_ROPE); const float* rope_s = rope_c + 2048;
    bf16* Od = (bf16*)(F.ws + (dir == 0 ? WS_OF : WS_OB));
    const int i_row = F.tid >> 3, sub = F.tid & 7, hs = sub >> 2, g = sub & 3, da = hs * 64 + g * 8, db = da + 32;
    const int w = F.wave, lane = F.lane, mt = w >> 1, ntb = (w & 1) * 2, et = w >> 1, dtb = (w & 1) * 4;
    for (int idx = F.tid; idx < 17408 / 4; idx += 512) ((unsigned*)(L + RT_ST))[idx] = 0u;
    f32x4 sacc[4];
#pragma unroll
    for (int q = 0; q < 4; ++q) sacc[q] = (f32x4){0.f, 0.f, 0.f, 0.f};
    const float gC = exp2f(lg2 * 64.f);
    const float kd = exp2f(lg2 * (float)(63 - i_row));
    constexpr int NCC = CTXL / 64, NCH = NCC + SEQ / 64;
    v4u rq[2], rk[2], rv;
#define RT_LOAD_RAW(c) do { const bool xph_ = (c) >= NCC; const int T_ = xph_ ? SEQ : CTXL; const int cc_ = xph_ ? (c) - NCC : (c); \
        const size_t base_ = xph_ ? (size_t)b * SEQ : (size_t)NX + (size_t)b * CTXL; const int s_ = cc_ * 64 + i_row; const int t_ = dir ? T_ - 1 - s_ : s_; \
        const bf16* pr_ = P + (base_ + t_) * INC; \
        rq[0] = *(const v4u*)(pr_ + C_RQ + h * 128 + da); rq[1] = *(const v4u*)(pr_ + C_RQ + h * 128 + db); \
        rk[0] = *(const v4u*)(pr_ + C_RK + h * 128 + da); rk[1] = *(const v4u*)(pr_ + C_RK + h * 128 + db); \
        rv = *(const v4u*)(pr_ + C_RV + h * 128 + half * 64 + sub * 8); } while (0)
#define RT_STAGE(c) do { unsigned char* Lb_ = L + ((c) & 1) * RT_STG; const bool xph_ = (c) >= NCC; const int T_ = xph_ ? SEQ : CTXL; const int cc_ = xph_ ? (c) - NCC : (c); \
        float qa[8], qb[8], ka[8], kb[8], vv[8]; \
        unpack8(rq[0], qa); unpack8(rq[1], qb); unpack8(rk[0], ka); unpack8(rk[1], kb); unpack8(rv, vv); \
        if (xph_) { \
            const int s = cc_ * 64 + i_row, t = dir ? T_ - 1 - s : s; const int pos = hs ? (t & 63) : (t >> 6); \
            const f32x4 c0 = *(const f32x4*)(rope_c + pos * 32 + g * 8), c1 = *(const f32x4*)(rope_c + pos * 32 + g * 8 + 4); \
            const f32x4 s0 = *(const f32x4*)(rope_s + pos * 32 + g * 8), s1 = *(const f32x4*)(rope_s + pos * 32 + g * 8 + 4); \
            _Pragma("unroll") for (int j = 0; j < 8; ++j) { const float cn = j < 4 ? c0[j & 3] : c1[j & 3], sn = j < 4 ? s0[j & 3] : s1[j & 3]; \
                const float a = qa[j], bq = qb[j]; qa[j] = a * cn - bq * sn; qb[j] = a * sn + bq * cn; \
                const float a2 = ka[j], b2 = kb[j]; ka[j] = a2 * cn - b2 * sn; kb[j] = a2 * sn + b2 * cn; } \
        } \
        _Pragma("unroll") for (int j = 0; j < 8; ++j) { ka[j] *= 0.08838834764831845f; kb[j] *= 0.08838834764831845f; } \
        *(v4u*)(Lb_ + RT_Q + i_row * RT_S136 + da * 2) = pack8(qa); *(v4u*)(Lb_ + RT_Q + i_row * RT_S136 + db * 2) = pack8(qb); \
        *(v4u*)(Lb_ + RT_K + i_row * RT_S136 + da * 2) = pack8(ka); *(v4u*)(Lb_ + RT_K + i_row * RT_S136 + db * 2) = pack8(kb); \
        _Pragma("unroll") for (int j = 0; j < 8; ++j) { \
            *(bf16*)(Lb_ + RT_KT + (da + j) * RT_S72 + i_row * 2) = (bf16)f2bf(ka[j] * kd); \
            *(bf16*)(Lb_ + RT_KT + (db + j) * RT_S72 + i_row * 2) = (bf16)f2bf(kb[j] * kd); \
            *(bf16*)(Lb_ + RT_VT + (sub * 8 + j) * RT_S72 + i_row * 2) = (bf16)f2bf(vv[j]); } } while (0)
    RT_LOAD_RAW(0);
    RT_STAGE(0);
    RT_LOAD_RAW(1);
    for (int c = 0; c < NCH; ++c) {
        const bool xph = c >= NCC; const int T = xph ? SEQ : CTXL; const int cc = xph ? c - NCC : c;
        const unsigned char* Lb = L + (c & 1) * RT_STG;
        __syncthreads();
        f32x4 oacc[2];
        {
            bf16x8 qf[4];
#pragma unroll
            for (int ks = 0; ks < 4; ++ks) qf[ks] = ldfrag(Lb + RT_Q, RT_S136, mt * 16, ks * 32, lane);
#pragma unroll
            for (int n2 = 0; n2 < 2; ++n2) {
                f32x4 a = {0.f, 0.f, 0.f, 0.f}, sc = {0.f, 0.f, 0.f, 0.f};
#pragma unroll
                for (int ks = 0; ks < 4; ++ks) { a = MFMA16(qf[ks], ldfrag(L + RT_ST, RT_S136, (ntb + n2) * 16, ks * 32, lane), a);
                                                 sc = MFMA16(qf[ks], ldfrag(Lb + RT_K, RT_S136, (ntb + n2) * 16, ks * 32, lane), sc); }
#pragma unroll
                for (int j = 0; j < 4; ++j) { const int i = mt * 16 + (lane >> 4) * 4 + j; const int jj = (ntb + n2) * 16 + (lane & 15); const int dist = i - jj;
                    a[j] *= exp2f(lg2 * (float)(i + 1));
                    const bool ok = dir ? (dist > 0) : (dist >= 0);
                    const float pv = ok ? sc[j] * exp2f(lg2 * (float)dist) : 0.f;
                    *(bf16*)(L + RT_P + i * RT_S72 + jj * 2) = (bf16)f2bf(pv); }
                oacc[n2] = a;
            }
        }
        if (c + 1 < NCH) { RT_STAGE(c + 1); if (c + 2 < NCH) RT_LOAD_RAW(c + 2); }
        __syncthreads();
        {
#pragma unroll
            for (int ks = 0; ks < 2; ++ks) { const bf16x8 pf = ldfrag(L + RT_P, RT_S72, mt * 16, ks * 32, lane);
#pragma unroll
                for (int n2 = 0; n2 < 2; ++n2) oacc[n2] = MFMA16(pf, ldfrag(Lb + RT_VT, RT_S72, (ntb + n2) * 16, ks * 32, lane), oacc[n2]); }
            if (xph) {
#pragma unroll
                for (int n2 = 0; n2 < 2; ++n2)
#pragma unroll
                    for (int j = 0; j < 4; ++j) { const int i = mt * 16 + (lane >> 4) * 4 + j; const int s = cc * 64 + i, t = dir ? T - 1 - s : s; const int e = (ntb + n2) * 16 + (lane & 15);
                        Od[((size_t)b * SEQ + t) * 512 + h * 128 + half * 64 + e] = (bf16)f2bf(oacc[n2][j]); }
            }
        }
        {
#pragma unroll
            for (int q = 0; q < 4; ++q) sacc[q] = sacc[q] * gC;
#pragma unroll
            for (int ks = 0; ks < 2; ++ks) { const bf16x8 vf = ldfrag(Lb + RT_VT, RT_S72, et * 16, ks * 32, lane);
#pragma unroll
                for (int q = 0; q < 4; ++q) sacc[q] = MFMA16(vf, ldfrag(Lb + RT_KT, RT_S72, (dtb + q) * 16, ks * 32, lane), sacc[q]); }
#pragma unroll
            for (int q = 0; q < 4; ++q)
#pragma unroll
                for (int j = 0; j < 4; ++j) { const int e = et * 16 + (lane >> 4) * 4 + j, dd = (dtb + q) * 16 + (lane & 15);
                    *(bf16*)(L + RT_ST + e * RT_S136 + dd * 2) = (bf16)f2bf(sacc[q][j]); }
        }
    }
    __syncthreads();
#undef RT_LOAD_RAW
#undef RT_STAGE
}

constexpr int MG_SG = 0, MG_G = 17408, MG_GSTRIDE = 1040;
__device__ __forceinline__ void merge_phase(Frame& F) {
    unsigned char* L = F.lds;
    const bf16* P = (const bf16*)(F.ws + WS_P);
    const bf16* YF = (const bf16*)(F.ws + WS_YF); const bf16* YB = (const bf16*)(F.ws + WS_YB);
    const bf16* OF = (const bf16*)(F.ws + WS_OF); const bf16* OB = (const bf16*)(F.ws + WS_OB);
    const float* BON = (const float*)(F.ws + WS_BONUS);
    const unsigned char* GUPT = F.ws + WS_GUPT;
    bf16* MIXA = (bf16*)(F.ws + WS_MIXA);
    const float* mu = F.in[10];
    const int i_row = F.tid >> 3, sub = F.tid & 7, w = F.wave, lane = F.lane;
    float cm0[8], cm1[8], clw[8], clb[8];
    ld8f(mu + (C_WV - 2048) + lane * 8, cm0); ld8f(mu + 1792 + (C_WV - 2048) + lane * 8, cm1); ld8f(F.in[19] + lane * 8, clw); ld8f(F.in[20] + lane * 8, clb);
    for (int tl = F.bid; tl < NX / 64; tl += F.G) {
        const int m = tl * 64 + i_row, t = m & (SEQ - 1);
        const bf16* pr = P + (size_t)m * INC;
        bf16x8 gfr[4][4];
#pragma unroll
        for (int nt = 0; nt < 4; ++nt)
#pragma unroll
            for (int ks = 0; ks < 4; ++ks) gfr[nt][ks] = ldfrag(GUPT, 256, w * 64 + nt * 16, ks * 32, lane);
        {
#pragma unroll
            for (int q = 0; q < 2; ++q) { const int col = sub * 16 + q * 8;
                float p[8], pp[8], pn[8], o[8];
                unpack8(*(const v4u*)(pr + C_GL + col), p);
                if (t > 0) unpack8(*(const v4u*)(pr - INC + C_GL + col), pp); else { for (int j = 0; j < 8; ++j) pp[j] = 0.f; }
                if (t < SEQ - 1) unpack8(*(const v4u*)(pr + INC + C_GL + col), pn); else { for (int j = 0; j < 8; ++j) pn[j] = 0.f; }
                float m0[8], m1[8]; ld8f(mu + (C_GL - 2048) + col, m0); ld8f(mu + 1792 + (C_GL - 2048) + col, m1);
#pragma unroll
                for (int j = 0; j < 8; ++j) o[j] = sigmoidf_(p[j] + m0[j] * (pp[j] - p[j]) + m1[j] * (pn[j] - p[j]));
                *(v4u*)(L + MG_SG + i_row * RT_S136 + col * 2) = pack8(o); }
        }
        __syncthreads();
        {
#pragma unroll
            for (int mt = 0; mt < 4; ++mt) {
                f32x4 acc[4];
#pragma unroll
                for (int nt = 0; nt < 4; ++nt) acc[nt] = (f32x4){0.f, 0.f, 0.f, 0.f};
#pragma unroll
                for (int ks = 0; ks < 4; ++ks) { const bf16x8 af = ldfrag(L + MG_SG, RT_S136, mt * 16, ks * 32, lane);
#pragma unroll
                    for (int nt = 0; nt < 4; ++nt) acc[nt] = MFMA16(gfr[nt][ks], af, acc[nt]); }
#pragma unroll
                for (int nt = 0; nt < 4; ++nt) { v2u o_; o_.x = pk2(acc[nt][0], acc[nt][1]); o_.y = pk2(acc[nt][2], acc[nt][3]);
                    *(v2u*)(L + MG_G + (mt * 16 + (lane & 15)) * MG_GSTRIDE + (w * 64 + nt * 16 + (lane >> 4) * 4) * 2) = o_; }
            }
        }
        __syncthreads();
#pragma unroll 2
        for (int tt = 0; tt < 8; ++tt) {
            const int ti = tt * 8 + w, mm = tl * 64 + ti, t2 = mm & (SEQ - 1);
            const bf16* pr2 = P + (size_t)mm * INC;
            const int col = lane * 8;
            {
                float a[8], bb[8], y[8], p8[8], pp[8], pn[8], gg[8], o[8];
                unpack8(__builtin_nontemporal_load((const v4u*)(YF + (size_t)mm * 512 + col)), a); unpack8(__builtin_nontemporal_load((const v4u*)(YB + (size_t)mm * 512 + col)), bb);
                unpack8(*(const v4u*)(pr2 + C_WV + col), p8);
                if (t2 > 0) unpack8(*(const v4u*)(pr2 - INC + C_WV + col), pp); else { for (int j = 0; j < 8; ++j) pp[j] = 0.f; }
                if (t2 < SEQ - 1) unpack8(*(const v4u*)(pr2 + INC + C_WV + col), pn); else { for (int j = 0; j < 8; ++j) pn[j] = 0.f; }
                const float bonus = BON[(size_t)mm * 8 + (lane >> 3)];
                unpack8(*(const v4u*)(L + MG_G + ti * MG_GSTRIDE + col * 2), gg);
                float s = 0.f, s2 = 0.f;
#pragma unroll
                for (int j = 0; j < 8; ++j) { y[j] = a[j] + bb[j]; s += y[j]; s2 += y[j] * y[j]; }
                s = red8(s); s2 = red8(s2);
                const float mean = s * (1.f / 64.f);
                const float rstd = __builtin_amdgcn_rsqf(fmaxf(s2 * (1.f / 64.f) - mean * mean, 0.f) + 64e-5f);
#pragma unroll
                for (int j = 0; j < 8; ++j) {
                    const float vsft = p8[j] + cm0[j] * (pp[j] - p8[j]) + cm1[j] * (pn[j] - p8[j]);
                    o[j] = ((y[j] - mean) * rstd * clw[j] + clb[j] + bonus * vsft) * gg[j]; }
                *(v4u*)(MIXA + (size_t)mm * DM + 512 + col) = pack8(o);
            }
            {
                float a[8], bb[8], gt[8], r[8]; float ss = 0.f;
                unpack8(__builtin_nontemporal_load((const v4u*)(OF + (size_t)mm * 512 + col)), a); unpack8(__builtin_nontemporal_load((const v4u*)(OB + (size_t)mm * 512 + col)), bb);
                unpack8(*(const v4u*)(pr2 + C_RG + col), gt);
#pragma unroll
                for (int j = 0; j < 8; ++j) { a[j] += bb[j]; ss += a[j] * a[j]; }
                ss = red16(ss);
                const float rms = __builtin_amdgcn_rsqf(ss * (1.f / 128.f) + 1e-6f);
#pragma unroll
                for (int j = 0; j < 8; ++j) r[j] = a[j] * rms * (gt[j] * sigmoidf_(gt[j]));
                *(v4u*)(MIXA + (size_t)mm * DM + col) = pack8(r);
            }
        }
    }
    __syncthreads();
}

#define LAS __attribute__((address_space(3)))
#define XB_TMO      128
#define XB_XCNT(j)  (256  + 64 * (j))
#define XB_XSUB(j)  (1280 + 64 * (j))
#define XB_XGEN(j)  (2304 + 64 * (j))
#define XB_TOP      3328
#define XB_TOPGEN   3392
#define XCD_BAR_WORDS 3456
#define XB_SPIN_CAP (1u << 18)

__device__ __forceinline__ unsigned xb_ld(unsigned* p)              { return __hip_atomic_load(p, __ATOMIC_RELAXED, __HIP_MEMORY_SCOPE_AGENT); }
__device__ __forceinline__ unsigned xb_add(unsigned* p, unsigned v) { return __hip_atomic_fetch_add(p, v, __ATOMIC_RELAXED, __HIP_MEMORY_SCOPE_AGENT); }
__device__ __forceinline__ unsigned xb_xcc_id() { return (unsigned)__builtin_amdgcn_s_getreg((3 << 11) | 20) & 0xFu; }
#define XB_SPIN(cond, bar) do { unsigned _sp = 0; while (cond) { __builtin_amdgcn_s_sleep(1); \
    if ((++_sp & 255u) == 0u) { if (xb_ld(&(bar)[XB_TMO])) break; if (_sp > XB_SPIN_CAP) { atomicAdd(&(bar)[XB_TMO], 1u); break; } } } } while (0)

struct XcdBarrier {
    unsigned* bar; unsigned x;
    volatile LAS unsigned* st;
};

__device__ __forceinline__ XcdBarrier xcd_barrier_post(unsigned* bar, volatile LAS unsigned* st) {
    XcdBarrier b; b.bar = bar; b.x = xb_xcc_id(); b.st = st;
    if (threadIdx.x == 0) (void)xb_add(&bar[XB_XCNT(b.x)], 1u);
    return b;
}
__device__ __forceinline__ void xcd_barrier_complete(unsigned* bar, unsigned x, unsigned& nloc, unsigned& nx) {
    const unsigned G = gridDim.x * gridDim.y * gridDim.z;
    unsigned sum, cnt, mine, sp = 0u;
    for (;;) {
        sum = 0u; cnt = 0u; mine = 0u;
#pragma unroll
        for (unsigned j = 0; j < 16; ++j) { const unsigned c = xb_ld(&bar[XB_XCNT(j)]); sum += c; cnt += (c > 0u) ? 1u : 0u; mine = (j == x) ? c : mine; }
        if (sum == G) break;
        __builtin_amdgcn_s_sleep(1);
        if ((++sp & 255u) == 0u) { if (xb_ld(&bar[XB_TMO])) break; if (sp > XB_SPIN_CAP) { atomicAdd(&bar[XB_TMO], 1u); break; } }
    }
    nloc = mine > 0u ? mine : 1u; nx = cnt > 0u ? cnt : 1u;
}

__device__ __forceinline__ void xcd_barrier(const XcdBarrier& b) {
    asm volatile("s_waitcnt vmcnt(0)" ::: "memory");
    __syncthreads();
    if (threadIdx.x == 0) {
        unsigned* bar = b.bar;
        __builtin_amdgcn_s_waitcnt(0);
        unsigned nloc = b.st[0], nx = b.st[1];
        if (nloc == 0u) { xcd_barrier_complete(bar, b.x, nloc, nx); b.st[0] = nloc; b.st[1] = nx; }
        const unsigned old = xb_add(&bar[XB_XSUB(b.x)], 1u);
        const unsigned gen = old / nloc;
        if (old + 1u == (gen + 1u) * nloc) {
            __builtin_amdgcn_fence(__ATOMIC_RELEASE, "agent");
            asm volatile("s_waitcnt vmcnt(0)" ::: "memory");
            const unsigned og = xb_add(&bar[XB_TOP], 1u);
            const unsigned tg = og / nx;
            if (og + 1u == (tg + 1u) * nx) xb_add(&bar[XB_TOPGEN], 1u);
            else XB_SPIN(xb_ld(&bar[XB_TOPGEN]) == tg, bar);
            __builtin_amdgcn_fence(__ATOMIC_ACQUIRE, "agent");
            xb_add(&bar[XB_XGEN(b.x)], 1u);
            asm volatile("s_waitcnt vmcnt(0)" ::: "memory");
        } else {
            XB_SPIN(xb_ld(&bar[XB_XGEN(b.x)]) == gen, bar);
            __builtin_amdgcn_fence(__ATOMIC_ACQUIRE, "agent");
            asm volatile("s_waitcnt vmcnt(0)" ::: "memory");
        }
    }
    __syncthreads();
}

struct Args { const float* in[27]; float* out; unsigned char* ws; int never; int pad; };
__global__ void __launch_bounds__(NWAVES * 64, 2) fwd_megakernel(Args args) {
    extern __shared__ __attribute__((aligned(16))) unsigned char lds[];
    cg::grid_group grid = cg::this_grid();
    Frame F;
    F.lds = lds; F.tid = threadIdx.x; F.lane = F.tid & 63; F.wave = __builtin_amdgcn_readfirstlane(F.tid >> 6); F.G = gridDim.x; F.bid = blockIdx.x;
#pragma unroll
    for (int i = 0; i < 27; ++i) F.in[i] = args.in[i];
    F.out = args.out; F.ws = args.ws;
    PG8_LAS unsigned char* glds = (PG8_LAS unsigned char*)lds;
    for (int u = F.tid; u < 16; u += NWAVES * 64) ((unsigned*)(lds + LDS_BYTES - 64))[u] = 0u;
    __syncthreads();
    XcdBarrier xbar = xcd_barrier_post((unsigned*)(F.ws + WS_CTL), (volatile LAS unsigned*)(lds + LDS_BYTES - 64));
    if (args.never) grid.sync();
#define GRID_SYNC() do { xcd_barrier(xbar); asm volatile("" : "+v"(F.tid)); F.lane = F.tid & 63; } while (0)

    p0_phase(F);
    GRID_SYNC();
    norm_phase<0>(F);
    cmat_phase(F);
    GRID_SYNC();
    {
        pg8::Gemm g{(const pg8::bf16_t*)(F.ws + WS_XN), (const pg8::bf16_t*)(F.ws + WS_WIN), NTOK, INC, DM}; pg8::StaticOrder S; S.init(NTOK, INC, F.G, F.bid);
        pg8::EpiBf16<0> E{(pg8::bf16_t*)(F.ws + WS_P), INC, nullptr};
        pg8::gemm_phase<pg8::EpiBf16<0>, pg8::StaticOrder, true, true>(glds, g, S, E);
        const int nun = (NTOK / 256) * (INC / 256);
        wconv_tail(F, (nun % F.G) ? (nun % F.G) : 0);
    }
    GRID_SYNC();
    for (int sid = F.bid; sid < 256; sid += F.G) rwkv_scan_unit(F, sid);
    asm volatile("" : "+v"(F.tid)); F.lane = F.tid & 63;
    for (int rid = F.bid; rid < 256; rid += F.G) ret_unit(F, rid);
    GRID_SYNC();
    merge_phase(F);
    GRID_SYNC();
    {
        pg8::Gemm g{(const pg8::bf16_t*)(F.ws + WS_MIXA), (const pg8::bf16_t*)(F.ws + WS_WOUT), NX, DM, DM}; pg8::StaticOrder S; S.init(NX, DM, F.G, F.bid);
        pg8::EpiResidNorm E{F.in[0], F.out, DM, (const float*)(F.ws + WS_ADA) + 2 * DM, ADA_LD, SEQ, F.in[7], (const float*)(F.ws + WS_ADA) + 4 * DM, (pg8::bf16_t*)(F.ws + WS_XN2), (float*)(F.ws + WS_SS)};
        pg8::gemm_phase<pg8::EpiResidNorm, pg8::StaticOrder, true, true>(glds, g, S, E);
    }
    GRID_SYNC();
    {
        pg8::Gemm g{(const pg8::bf16_t*)(F.ws + WS_XN2), (const pg8::bf16_t*)(F.ws + WS_W1), NX, DFF, DM}; pg8::StaticOrder S; S.init(NX, DFF, F.G, F.bid);
        pg8::EpiBf16Row E{(pg8::bf16_t*)(F.ws + WS_P), DFF, (const float*)(F.ws + WS_CMAT), SEQ, (const float*)(F.ws + WS_SS), 1.0f / DM, 1e-6f};
        pg8::gemm_phase<pg8::EpiBf16Row, pg8::StaticOrder, true, true>(glds, g, S, E);
    }
    GRID_SYNC();
    {
        pg8::Gemm g{(const pg8::bf16_t*)(F.ws + WS_P), (const pg8::bf16_t*)(F.ws + WS_W2), NX, DM, DFF}; pg8::StaticOrder S; S.init(NX, DM, F.G, F.bid);
        pg8::EpiResid E{F.out, F.out, DM, F.in[25], (const float*)(F.ws + WS_ADA) + 5 * DM, ADA_LD, SEQ};
        pg8::gemm_phase<pg8::EpiResid, pg8::StaticOrder, true, true>(glds, g, S, E);
    }
    GRID_SYNC();
    norm_phase<2>(F);
}

extern "C" void kernel_launch(void* const* d_in, const int* in_sizes, int n_in, void* d_out, int out_size, void* d_ws, size_t ws_size, hipStream_t stream) {
    static int grid = 0;
    if (grid == 0) {
        if (n_in != 27 || in_sizes[0] != NX * DM || out_size != NX * DM || ws_size < WS_END) { fprintf(stderr, "kernel_launch: unexpected shapes (n_in %d, in0 %d, out %d, ws %zu)\n", n_in, n_in > 0 ? in_sizes[0] : -1, out_size, ws_size); grid = -1; return; }
        int dev = 0, cus = 0, per_cu = 0;
        if (hipGetDevice(&dev) != hipSuccess || hipDeviceGetAttribute(&cus, hipDeviceAttributeMultiprocessorCount, dev) != hipSuccess) { grid = -1; return; }
        if (hipFuncSetAttribute((const void*)fwd_megakernel, hipFuncAttributeMaxDynamicSharedMemorySize, LDS_BYTES) != hipSuccess) { fprintf(stderr, "kernel_launch: hipFuncSetAttribute failed\n"); grid = -1; return; }
        if (hipOccupancyMaxActiveBlocksPerMultiprocessor(&per_cu, (const void*)fwd_megakernel, NWAVES * 64, LDS_BYTES) != hipSuccess || per_cu < 1) { fprintf(stderr, "kernel_launch: occupancy query says %d\n", per_cu); per_cu = 1; }
        (void)hipGetLastError();
        grid = cus;
    }
    if (grid < 0) return;
    if (hipMemsetAsync((char*)d_ws + WS_CTL, 0, 512 * 1024, stream) != hipSuccess) { fprintf(stderr, "kernel_launch: memset failed\n"); return; }
    Args a{};
    for (int i = 0; i < 27; ++i) a.in[i] = (const float*)d_in[i];
    a.out = (float*)d_out; a.ws = (unsigned char*)d_ws; a.never = 0; a.pad = 0;
    void* kargs[] = {&a};
    hipError_t e = hipLaunchCooperativeKernel((const void*)fwd_megakernel, dim3(grid), dim3(NWAVES * 64), kargs, LDS_BYTES, stream);
    if (e != hipSuccess) fprintf(stderr, "kernel_launch: cooperative launch failed: %s (grid %d)\n", hipGetErrorString(e), grid);
}
```
